# Optimizing an MI355X kernel written in HIP

```python
import jax, jax.numpy as jnp
from jax import lax
import numpy as np

D_MODEL = 1024
BATCH = 8
SEQ = 2048
DEPTH = 4

MIX_WIDTH = 2 * D_MODEL
CHUNK = 128
GMLP_WIDTH = MIX_WIDTH // 2
GMLP_HEADS = 8
GMLP_HEAD_DIM = GMLP_WIDTH // GMLP_HEADS
SSD_WIDTH = MIX_WIDTH - GMLP_WIDTH
SSD_HEAD_DIM = 64
SSD_HEADS = SSD_WIDTH // SSD_HEAD_DIM
SSD_GROUPS = 4
HEADS_PER_GROUP = SSD_HEADS // SSD_GROUPS
D_STATE = 128
CONV_WIDTH = 4
CONV_DIM = SSD_WIDTH + 2 * SSD_GROUPS * D_STATE
IN_COLS = 3 * GMLP_WIDTH + SSD_WIDTH + CONV_DIM + SSD_HEADS
SPLITS = (GMLP_WIDTH, 2 * GMLP_WIDTH, 3 * GMLP_WIDTH,
          3 * GMLP_WIDTH + SSD_WIDTH, 3 * GMLP_WIDTH + SSD_WIDTH + CONV_DIM)
EPS = 1e-6
DT_MIN = 1e-3
DT_MAX = 1e-1

kernel_name = "hymba_gmlp_ssd_hybrid"


def rms_norm(x, w):
    xf = x.astype(jnp.float32)
    y = xf * lax.rsqrt(jnp.mean(xf * xf, axis=-1, keepdims=True) + EPS)
    return (y * w.astype(jnp.float32)).astype(x.dtype)


def grouped_rms_norm(x, w, group_size):
    shp = x.shape
    xf = x.astype(jnp.float32).reshape(*shp[:-1], shp[-1] // group_size, group_size)
    y = xf * lax.rsqrt(jnp.mean(xf * xf, axis=-1, keepdims=True) + EPS)
    return (y.reshape(shp) * w.astype(jnp.float32)).astype(x.dtype)


def layer_norm(x, w, b):
    xf = x.astype(jnp.float32)
    mu = jnp.mean(xf, axis=-1, keepdims=True)
    xc = xf - mu
    y = xc * lax.rsqrt(jnp.mean(xc * xc, axis=-1, keepdims=True) + EPS)
    return (y * w.astype(jnp.float32) + b.astype(jnp.float32)).astype(x.dtype)


def causal_depthwise_conv(x, w, b):
    k, c = w.shape
    out = lax.conv_general_dilated(
        x, w[:, None, :].astype(x.dtype), window_strides=(1,), padding=[(k - 1, 0)],
        dimension_numbers=('NWC', 'WIO', 'NWC'), feature_group_count=c)
    return out + b.astype(x.dtype)


def spatial_gating(u, v, zg, v_norm_w, v_norm_b, ws, bs, out_norm_w):
    bsz, seq, _ = u.shape
    nc = seq // CHUNK
    vn = layer_norm(v, v_norm_w, v_norm_b).reshape(bsz, nc, CHUNK, GMLP_HEADS, GMLP_HEAD_DIM)
    causal = jnp.tril(jnp.ones((CHUNK, CHUNK), dtype=bool))
    ws_c = jnp.where(causal[None], ws, 0.0)
    s = jnp.einsum('hts,bcshd->bcthd', ws_c.astype(vn.dtype), vn) + bs.T[None, None, :, :, None]
    s = s.reshape(bsz, seq, GMLP_WIDTH)
    y = u * s * jax.nn.silu(zg)
    return grouped_rms_norm(y, out_norm_w, GMLP_HEAD_DIM)


def ssd_mixer(xbc, z, dt_raw, conv_w, conv_b, dt_bias, a_log, d_skip, norm_w):
    bsz, seq, _ = xbc.shape
    nc = seq // CHUNK
    f32 = jnp.float32
    xbc = jax.nn.silu(causal_depthwise_conv(xbc, conv_w, conv_b))
    xs, bm, cm = jnp.split(xbc, [SSD_WIDTH, SSD_WIDTH + SSD_GROUPS * D_STATE], axis=-1)
    xs = xs.astype(f32).reshape(bsz, nc, CHUNK, SSD_GROUPS, HEADS_PER_GROUP, SSD_HEAD_DIM)
    bm = bm.astype(f32).reshape(bsz, nc, CHUNK, SSD_GROUPS, D_STATE)
    cm = cm.astype(f32).reshape(bsz, nc, CHUNK, SSD_GROUPS, D_STATE)
    dt = jax.nn.softplus(dt_raw.astype(f32) + dt_bias.astype(f32))
    dt = dt.reshape(bsz, nc, CHUNK, SSD_GROUPS, HEADS_PER_GROUP)
    a = -jnp.exp(a_log.astype(f32)).reshape(SSD_GROUPS, HEADS_PER_GROUP)
    da_cs = jnp.cumsum(dt * a, axis=2)
    xdt = xs * dt[..., None]
    causal = jnp.tril(jnp.ones((CHUNK, CHUNK), dtype=bool))[None, None, :, :, None, None]
    seg = da_cs[:, :, :, None] - da_cs[:, :, None, :]
    decay = jnp.exp(jnp.where(causal, seg, -jnp.inf))
    cb = jnp.einsum('bclgn,bcsgn->bclsg', cm, bm)
    y_diag = jnp.einsum('bclsg,bclsgr,bcsgrp->bclgrp', cb, decay, xdt)
    decay_to_end = jnp.exp(da_cs[:, :, -1:] - da_cs)
    states = jnp.einsum('bclgn,bclgr,bclgrp->bcgrpn', bm, decay_to_end, xdt)
    chunk_decay = jnp.exp(da_cs[:, :, -1])

    def step(carry, inp):
        st, dec = inp
        return carry * dec[..., None, None] + st, carry

    init = jnp.zeros_like(states[:, 0])
    _, prev_states = lax.scan(step, init, (jnp.moveaxis(states, 1, 0), jnp.moveaxis(chunk_decay, 1, 0)))
    prev_states = jnp.moveaxis(prev_states, 0, 1)
    y_off = jnp.einsum('bclgn,bcgrpn,bclgr->bclgrp', cm, prev_states, jnp.exp(da_cs))
    d = d_skip.astype(f32).reshape(SSD_GROUPS, HEADS_PER_GROUP)[:, :, None]
    y = (y_diag + y_off + xs * d).reshape(bsz, seq, SSD_WIDTH).astype(z.dtype)
    return grouped_rms_norm(y * jax.nn.silu(z), norm_w, SSD_WIDTH // SSD_GROUPS)


def hybrid_layer(x, pre_w, w_in, v_norm_w, v_norm_b, ws, bs, gmlp_norm_w,
                 conv_w, conv_b, dt_bias, a_log, d_skip, ssd_norm_w, w_out, post_w):
    h = rms_norm(x, pre_w)
    proj = jnp.einsum('bld,dc->blc', h, w_in)
    u, v, zg, z, xbc, dt_raw = jnp.split(proj, SPLITS, axis=-1)
    y_a = spatial_gating(u, v, zg, v_norm_w, v_norm_b, ws, bs, gmlp_norm_w)
    y_b = ssd_mixer(xbc, z, dt_raw, conv_w, conv_b, dt_bias, a_log, d_skip, ssd_norm_w)
    mixed = jnp.einsum('blc,cd->bld', jnp.concatenate([y_a, y_b], axis=-1), w_out)
    return x + rms_norm(mixed, post_w)


def setup_inputs(seed: int = 0) -> dict:
    key = jax.random.key(seed)
    ks = jax.random.split(key, 18)
    nrm = jax.random.normal
    dt = jnp.exp(jax.random.uniform(ks[10], (DEPTH, SSD_HEADS)) * (np.log(DT_MAX) - np.log(DT_MIN)) + np.log(DT_MIN))
    return {
        "x": nrm(ks[0], (BATCH, SEQ, D_MODEL), jnp.float32),
        "pre_norm_w": 1.0 + 0.02 * nrm(ks[1], (DEPTH, D_MODEL)),
        "w_in": nrm(ks[2], (DEPTH, D_MODEL, IN_COLS)) * D_MODEL ** -0.5,
        "gmlp_v_norm_w": 1.0 + 0.02 * nrm(ks[3], (DEPTH, GMLP_WIDTH)),
        "gmlp_v_norm_b": 0.02 * nrm(ks[4], (DEPTH, GMLP_WIDTH)),
        "gmlp_ws": nrm(ks[5], (DEPTH, GMLP_HEADS, CHUNK, CHUNK)) * CHUNK ** -0.5,
        "gmlp_bs": 1.0 + 0.02 * nrm(ks[6], (DEPTH, GMLP_HEADS, CHUNK)),
        "gmlp_norm_w": 1.0 + 0.02 * nrm(ks[7], (DEPTH, GMLP_WIDTH)),
        "conv_w": nrm(ks[8], (DEPTH, CONV_WIDTH, CONV_DIM)) * CONV_WIDTH ** -0.5,
        "conv_b": 0.02 * nrm(ks[9], (DEPTH, CONV_DIM)),
        "dt_bias": dt + jnp.log(-jnp.expm1(-dt)),
        "a_log": jnp.log(jax.random.uniform(ks[11], (DEPTH, SSD_HEADS), minval=1.0, maxval=16.0)),
        "d_skip": 1.0 + 0.02 * nrm(ks[12], (DEPTH, SSD_HEADS)),
        "ssd_norm_w": 1.0 + 0.02 * nrm(ks[13], (DEPTH, SSD_WIDTH)),
        "w_out": nrm(ks[14], (DEPTH, MIX_WIDTH, D_MODEL)) * MIX_WIDTH ** -0.5,
        "post_norm_w": 1.0 + 0.02 * nrm(ks[15], (DEPTH, D_MODEL)),
    }


def reference(x, pre_norm_w, w_in, gmlp_v_norm_w, gmlp_v_norm_b, gmlp_ws, gmlp_bs, gmlp_norm_w,
              conv_w, conv_b, dt_bias, a_log, d_skip, ssd_norm_w, w_out, post_norm_w):
    h = x
    for i in range(DEPTH):
        h = hybrid_layer(h, pre_norm_w[i], w_in[i], gmlp_v_norm_w[i], gmlp_v_norm_b[i],
                         gmlp_ws[i], gmlp_bs[i], gmlp_norm_w[i], conv_w[i], conv_b[i],
                         dt_bias[i], a_log[i], d_skip[i], ssd_norm_w[i], w_out[i], post_norm_w[i])
    return h
```

```cpp
#include <hip/hip_runtime.h>
#include <cstdio>
#include <cstdint>
namespace pg8 {
#define PG8_LAS __attribute__((address_space(3)))
typedef unsigned short bf16_t;
typedef short bf16x8 __attribute__((ext_vector_type(8)));
typedef float f32x4 __attribute__((ext_vector_type(4)));
typedef unsigned u32x4 __attribute__((ext_vector_type(4)));
constexpr int BM = 256, BK = 64, HALF = 128, HTB = HALF * BK * 2  , STAGE_BYTES = 8 * HTB, NXCD = 8, WGM = 8;

__host__ __device__ __forceinline__ int lds_byte(int r, int c) { const int st = (r >> 4) * 2 + (c >> 5), rr = r & 15, cc = c & 31, ob = rr * 64 + cc * 2; return st * 1024 + (ob ^ (((ob >> 9) & 1) << 5)); }
__host__ __device__ __forceinline__ void stage_rc(int b, int& R, int& C) { const int st = b / 1024, sb = b % 1024, swz = sb ^ (((sb >> 9) & 1) << 5); R = (st >> 1) * 16 + swz / 64; C = (st & 1) * 32 + (swz % 64) / 2; }
__host__ __device__ __forceinline__ int perm32(int rho) { const int n = rho >> 4, i = rho & 15; return 8 * (i >> 2) + 4 * n + (i & 3); }

struct Unit { int pm, pn; };
struct Gemm { const bf16_t* A; const bf16_t* Bt; int M, N, K, lda; };

struct StaticOrder {
    int nM, nN, nwg, G, c;
    __host__ __device__ void init(int M, int N, int G_, int c_) { nM = M / BM; nN = N / BM; nwg = nM * nN; G = G_; c = c_; }
    __host__ __device__ bool next(int i, Unit& u) const {
        const long L = (long)i * G + c; if (L >= nwg) return false;
        int wgid = (int)L; { const int q = nwg / NXCD, r = nwg % NXCD, xcd = wgid % NXCD, off = wgid / NXCD; wgid = (xcd < r ? xcd * (q + 1) : r * (q + 1) + (xcd - r) * q) + off; }
        const int nig = WGM * nN, gid = wgid / nig, fm = gid * WGM, gsz = (nM - fm) < WGM ? (nM - fm) : WGM;
        u.pm = fm + ((wgid % nig) % gsz); u.pn = (wgid % nig) / gsz; return true;
    }
    __device__ __forceinline__ void a_ready(const Unit&) const {}
    __device__ __forceinline__ void done(const Unit&) const {}
};

__device__ __forceinline__ unsigned cvt_pk_bf16(float lo, float hi) { unsigned r; asm volatile("v_cvt_pk_bf16_f32 %0, %1, %2" : "=v"(r) : "v"(lo), "v"(hi)); return r; }
typedef float f32x2 __attribute__((ext_vector_type(2)));
__device__ __forceinline__ f32x2 gelu_pk(f32x2 v) {
    const f32x2 av = __builtin_elementwise_abs(v), d = av * 0.2316418882f + 1.0f;
    f32x2 t; t.x = __builtin_amdgcn_rcpf(d.x); t.y = __builtin_amdgcn_rcpf(d.y);
    f32x2 q = t * 0.5307027145f + (-0.7265760135f); q = q * t + 0.7107068705f; q = q * t + (-0.142248368f); q = q * t + 0.127414796f; q = q * t;
    const f32x2 s = (v * v) * (-0.72134752044f);
    f32x2 e; e.x = __builtin_amdgcn_exp2f(s.x); e.y = __builtin_amdgcn_exp2f(s.y);
    const f32x2 m = v * (q * e), r = v - m;
    f32x2 o; o.x = v.x < 0.f ? m.x : r.x; o.y = v.y < 0.f ? m.y : r.y; return o;
}

template <int ACT  > struct EpiBf16 {
    static constexpr bool PERM = true, AFTER_DRAIN = false; static_assert(ACT == 0 || ACT == 1, "EpiBf16: ACT is 0 (none) or 1 (gelu_pk)");
    bf16_t* O; int ldc; const float* bias; int split_cols; size_t split_stride; float scale0;
    __device__ __forceinline__ void operator()(const f32x4 (&acc)[2][2][4][2], const Unit& u, int wr, int wc, int fr, int fq) const {
        const int row0 = u.pm * BM + wr * 64 + fr; int colt = u.pn * BM; bf16_t* base = O;
        float sc = 1.f; if (split_cols) { const int t = colt / split_cols; base += (size_t)t * split_stride; colt -= t * split_cols; if (t == 0) sc = scale0; }
        const int col0 = colt + wc * 32 + 8 * fq, bcol0 = u.pn * BM + wc * 32 + 8 * fq;
        f32x4 bv[2][2];
#pragma unroll
        for (int bj = 0; bj < 2; ++bj)
#pragma unroll
            for (int n = 0; n < 2; ++n) bv[bj][n] = bias ? *(const f32x4*)(bias + bcol0 + bj * HALF + 4 * n) : (f32x4){0.f, 0.f, 0.f, 0.f};
#pragma unroll
        for (int ai = 0; ai < 2; ++ai)
#pragma unroll
            for (int m = 0; m < 4; ++m) { bf16_t* rowp = base + (size_t)(row0 + ai * HALF + m * 16) * ldc + col0;
#pragma unroll
                for (int bj = 0; bj < 2; ++bj) { f32x4 v0 = acc[ai][bj][m][0] + bv[bj][0], v1 = acc[ai][bj][m][1] + bv[bj][1];
                    if (ACT == 1) { f32x2 a = gelu_pk((f32x2){v0[0], v0[1]}), b = gelu_pk((f32x2){v0[2], v0[3]}), c = gelu_pk((f32x2){v1[0], v1[1]}), d = gelu_pk((f32x2){v1[2], v1[3]});
                        v0 = (f32x4){a.x, a.y, b.x, b.y}; v1 = (f32x4){c.x, c.y, d.x, d.y}; }
                    v0 = v0 * sc; v1 = v1 * sc; u32x4 w; w.x = cvt_pk_bf16(v0[0], v0[1]); w.y = cvt_pk_bf16(v0[2], v0[3]); w.z = cvt_pk_bf16(v1[0], v1[1]); w.w = cvt_pk_bf16(v1[2], v1[3]);
                    *(u32x4*)(rowp + bj * HALF) = w; } }
    }
};
struct EpiF32 {
    static constexpr bool PERM = false, AFTER_DRAIN = false;
    float* C; int ldc; const float* bias;
    __device__ __forceinline__ void operator()(const f32x4 (&acc)[2][2][4][2], const Unit& u, int wr, int wc, int fr, int fq) const {
        const int row0 = u.pm * BM + wr * 64 + fr, col0 = u.pn * BM + wc * 32 + 4 * fq;
        f32x4 bv[2][2];
#pragma unroll
        for (int bj = 0; bj < 2; ++bj)
#pragma unroll
            for (int n = 0; n < 2; ++n) bv[bj][n] = bias ? *(const f32x4*)(bias + col0 + bj * HALF + n * 16) : (f32x4){0.f, 0.f, 0.f, 0.f};
#pragma unroll
        for (int ai = 0; ai < 2; ++ai)
#pragma unroll
            for (int m = 0; m < 4; ++m) { float* rowp = C + (size_t)(row0 + ai * HALF + m * 16) * ldc + col0;
#pragma unroll
                for (int bj = 0; bj < 2; ++bj)
#pragma unroll
                    for (int n = 0; n < 2; ++n) *(f32x4*)(rowp + bj * HALF + n * 16) = acc[ai][bj][m][n] + bv[bj][n]; }
    }
};
template <class Epi, class Sched, bool ALIGN_EPI = false, bool SP2 = false>
__device__ __forceinline__ void gemm_phase(PG8_LAS unsigned char* lds, const Gemm g, const Sched& S, const Epi& E) {
    const int tid = threadIdx.x, wid = __builtin_amdgcn_readfirstlane(tid >> 6), lane = tid & 63, wr = wid >> 2, wc = wid & 3, fr = lane & 15, fq = lane >> 4;
    const int K = g.K, nt = K / BK;
    unsigned voffA[2], voffB[2];
#pragma unroll
    for (int i = 0; i < 2; ++i) { int R, C; stage_rc(tid * 16 + i * 8192, R, C); const int Rb = Epi::PERM ? ((R & ~31) + perm32(R & 31)) : R;
        voffA[i] = (unsigned)(R * g.lda + C) * 2u; voffB[i] = (unsigned)(Rb * K + C) * 2u; }
    const size_t kstep = (size_t)(BK * 2);
    const size_t hstepA = (size_t)HALF * g.lda * 2, hstepB = (size_t)HALF * K * 2;
    const size_t tstepA = 2 * hstepA, tstepB = 2 * hstepB;
    const unsigned ldsw = (unsigned)wid * 1024u;
    const int aoff = lds_byte(wr * 64 + fr, fq * 8), boff = lds_byte(wc * 32 + fr, fq * 8);
#define PG8_SA(b, h) (((b) * 2 + (h)) * HTB)
#define PG8_SB(b, h) ((4 + (b) * 2 + (h)) * HTB)
#define PG8_STAGE(bufoff, gbase, voff) do { _Pragma("unroll") for (int _i = 0; _i < 2; ++_i) \
        __builtin_amdgcn_global_load_lds((const unsigned*)((const char*)(gbase) + (voff)[_i]), (PG8_LAS unsigned*)(lds + (bufoff) + ldsw + _i * 8192), 16, 0, 0); } while (0)
#define PG8_LDA(dst, b, h) do { _Pragma("unroll") for (int m = 0; m < 4; ++m) _Pragma("unroll") for (int k = 0; k < 2; ++k) dst[m][k] = *(const PG8_LAS bf16x8*)(lds + PG8_SA(b, h) + aoff + m * 2048 + k * 1024); } while (0)
#define PG8_LDB(dst, b, h) do { _Pragma("unroll") for (int n = 0; n < 2; ++n) _Pragma("unroll") for (int k = 0; k < 2; ++k) dst[n][k] = *(const PG8_LAS bf16x8*)(lds + PG8_SB(b, h) + boff + n * 2048 + k * 1024); } while (0)
#define PG8_MMA(ai, bj, At, Bt) do { __builtin_amdgcn_s_setprio(1); _Pragma("unroll") for (int m = 0; m < 4; ++m) _Pragma("unroll") for (int n = 0; n < 2; ++n) _Pragma("unroll") for (int k = 0; k < 2; ++k) \
        acc[ai][bj][m][n] = __builtin_amdgcn_mfma_f32_16x16x32_bf16(Bt[n][k], At[m][k], acc[ai][bj][m][n], 0, 0, 0); __builtin_amdgcn_s_setprio(0); } while (0)
#define PG8_WAIT_V(n) asm volatile("s_waitcnt vmcnt(" #n ")" ::: "memory")
#define PG8_WAIT_L(n) asm volatile("s_waitcnt lgkmcnt(" #n ")" ::: "memory")
#define PG8_BAR __builtin_amdgcn_s_barrier()
#define PG8_SCHED __builtin_amdgcn_sched_barrier(0)
    Unit cur, nxt; int ui = 0;
    if (!S.next(0, cur)) return;
    f32x4 acc[2][2][4][2];
#pragma unroll
    for (int a = 0; a < 2; ++a)
#pragma unroll
        for (int b = 0; b < 2; ++b)
#pragma unroll
            for (int m = 0; m < 4; ++m)
#pragma unroll
                for (int n = 0; n < 2; ++n) acc[a][b][m][n] = (f32x4){0.f, 0.f, 0.f, 0.f};
    bf16x8 At[4][2], B0[2][2], B1[2][2];
    const char* cA = (const char*)g.A + (size_t)cur.pm * tstepA; const char* cB = (const char*)g.Bt + (size_t)cur.pn * tstepB;
    S.a_ready(cur);
    if constexpr (SP2) {
        PG8_STAGE(PG8_SB(0, 0), cB, voffB); PG8_STAGE(PG8_SB(0, 1), cB + hstepB, voffB); PG8_STAGE(PG8_SA(0, 0), cA, voffA); PG8_STAGE(PG8_SA(0, 1), cA + hstepA, voffA);
        if (wr == 1) PG8_BAR;
        PG8_WAIT_V(2); PG8_BAR;
        PG8_STAGE(PG8_SB(1, 0), cB + kstep, voffB); PG8_STAGE(PG8_SA(1, 0), cA + kstep, voffA); PG8_STAGE(PG8_SB(1, 1), cB + hstepB + kstep, voffB);
        PG8_WAIT_V(6); PG8_BAR;
    } else {
        PG8_STAGE(PG8_SB(0, 0), cB, voffB); PG8_STAGE(PG8_SA(0, 0), cA, voffA); PG8_STAGE(PG8_SB(0, 1), cB + hstepB, voffB); PG8_STAGE(PG8_SA(0, 1), cA + hstepA, voffA);
        if (wr == 1) PG8_BAR;
        PG8_WAIT_V(4); PG8_BAR;
        PG8_STAGE(PG8_SB(1, 0), cB + kstep, voffB); PG8_STAGE(PG8_SA(1, 0), cA + kstep, voffA); PG8_STAGE(PG8_SB(1, 1), cB + hstepB + kstep, voffB);
        PG8_WAIT_V(6); PG8_BAR;
    }
    for (;;) {
        const bool has_next = S.next(ui + 1, nxt);
        const char* nA = has_next ? (const char*)g.A + (size_t)nxt.pm * tstepA : cA; const char* nB = has_next ? (const char*)g.Bt + (size_t)nxt.pn * tstepB : cB;
        for (int t = 0; t < nt; t += 2) {
            const bool last = (t == nt - 2);
            const char* a1 = cA + (size_t)(t + 1) * kstep;
            const char* a2 = last ? nA : cA + (size_t)(t + 2) * kstep; const char* b2 = last ? nB : cB + (size_t)(t + 2) * kstep;
            const char* a3 = a2 + kstep; const char* b3 = b2 + kstep;
            if (last && has_next) S.a_ready(nxt);
            if constexpr (SP2) {
            PG8_LDB(B0, 0, 0); PG8_LDB(B1, 0, 1); PG8_SCHED; PG8_LDA(At, 0, 0); PG8_STAGE(PG8_SA(1, 1), a1 + hstepA, voffA);
            PG8_WAIT_V(8); PG8_WAIT_L(0); PG8_BAR; PG8_MMA(0, 0, At, B0); PG8_MMA(0, 1, At, B1); PG8_BAR; PG8_SCHED;
            PG8_LDA(At, 0, 1); PG8_STAGE(PG8_SB(0, 0), b2, voffB); PG8_STAGE(PG8_SB(0, 1), b2 + hstepB, voffB); PG8_STAGE(PG8_SA(0, 0), a2, voffA);
            PG8_WAIT_V(8); PG8_WAIT_L(0); PG8_BAR; PG8_MMA(1, 0, At, B0); PG8_MMA(1, 1, At, B1); PG8_BAR; PG8_SCHED;
            PG8_LDB(B0, 1, 0); PG8_LDB(B1, 1, 1); PG8_SCHED; PG8_LDA(At, 1, 0); PG8_STAGE(PG8_SA(0, 1), a2 + hstepA, voffA);
            PG8_WAIT_V(8); PG8_WAIT_L(0); PG8_BAR; PG8_MMA(0, 0, At, B0); PG8_MMA(0, 1, At, B1); PG8_BAR; PG8_SCHED;
            PG8_LDA(At, 1, 1); PG8_STAGE(PG8_SB(1, 0), b3, voffB); PG8_STAGE(PG8_SB(1, 1), b3 + hstepB, voffB); PG8_STAGE(PG8_SA(1, 0), a3, voffA);
            PG8_WAIT_V(8); PG8_WAIT_L(0); PG8_BAR; PG8_MMA(1, 0, At, B0); PG8_MMA(1, 1, At, B1); PG8_BAR; PG8_SCHED;
            } else {
            PG8_LDB(B0, 0, 0); PG8_SCHED; PG8_LDA(At, 0, 0); PG8_STAGE(PG8_SA(1, 1), a1 + hstepA, voffA);
            PG8_WAIT_L(8); PG8_BAR; PG8_WAIT_L(0); PG8_MMA(0, 0, At, B0); PG8_BAR; PG8_SCHED;
            PG8_LDB(B1, 0, 1); PG8_STAGE(PG8_SB(0, 0), b2, voffB);
            PG8_BAR; PG8_WAIT_L(0); PG8_MMA(0, 1, At, B1); PG8_BAR;
            PG8_LDA(At, 0, 1); PG8_STAGE(PG8_SA(0, 0), a2, voffA);
            PG8_BAR; PG8_WAIT_L(0); PG8_MMA(1, 0, At, B0); PG8_BAR; PG8_SCHED;
            PG8_STAGE(PG8_SB(0, 1), b2 + hstepB, voffB);
            PG8_WAIT_V(6); PG8_BAR; PG8_MMA(1, 1, At, B1); PG8_BAR;
            PG8_LDB(B0, 1, 0); PG8_SCHED; PG8_LDA(At, 1, 0); PG8_STAGE(PG8_SA(0, 1), a2 + hstepA, voffA);
            PG8_WAIT_L(8); PG8_BAR; PG8_WAIT_L(0); PG8_MMA(0, 0, At, B0); PG8_BAR; PG8_SCHED;
            PG8_LDB(B1, 1, 1); PG8_STAGE(PG8_SB(1, 0), b3, voffB);
            PG8_BAR; PG8_WAIT_L(0); PG8_MMA(0, 1, At, B1); PG8_BAR;
            PG8_LDA(At, 1, 1); PG8_STAGE(PG8_SA(1, 0), a3, voffA);
            PG8_BAR; PG8_WAIT_L(0); PG8_MMA(1, 0, At, B0); PG8_BAR; PG8_SCHED;
            PG8_STAGE(PG8_SB(1, 1), b3 + hstepB, voffB);
            PG8_WAIT_V(6); PG8_BAR; PG8_MMA(1, 1, At, B1); PG8_BAR;
            }
        }
        if constexpr (ALIGN_EPI) { if (wr == 0) PG8_BAR; }
        if constexpr (!Epi::AFTER_DRAIN) { E(acc, cur, wr, wc, fr, fq); S.done(cur); }
        if (!has_next) break;
#pragma unroll
        for (int a = 0; a < 2; ++a)
#pragma unroll
            for (int b = 0; b < 2; ++b)
#pragma unroll
                for (int m = 0; m < 4; ++m)
#pragma unroll
                    for (int n = 0; n < 2; ++n) acc[a][b][m][n] = (f32x4){0.f, 0.f, 0.f, 0.f};
        cur = nxt; cA = nA; cB = nB; ++ui;
        if constexpr (ALIGN_EPI) { if (wr == 1) PG8_BAR; }
    }
    PG8_WAIT_V(0);
    if constexpr (!ALIGN_EPI) { if (wr == 0) PG8_BAR; }
    PG8_BAR;
    if constexpr (Epi::AFTER_DRAIN) { E.fused(acc, cur, wr, wc, fr, fq, lds, wid, lane); S.done(cur); }
#undef PG8_SA
#undef PG8_SB
#undef PG8_STAGE
#undef PG8_LDA
#undef PG8_LDB
#undef PG8_MMA
#undef PG8_WAIT_V
#undef PG8_WAIT_L
#undef PG8_BAR
#undef PG8_SCHED
}
}

constexpr int M_TOK = 16384, DM = 1024, SEQ = 2048, NBATCH = 8, NCH = 16, CH = 128, DEPTH = 4;
constexpr int NPROJ = 6144, INCOLS = 6160;
constexpr int OFF_U = 0, OFF_V = 1024, OFF_ZG = 2048, OFF_Z = 3072, OFF_XBC = 4096;
constexpr int XC_X = 0, XC_B = 1024, XC_C = 1536;
constexpr float EPS = 1e-6f;
typedef unsigned short bf16;
typedef float f32x4 __attribute__((ext_vector_type(4)));
typedef unsigned v4u __attribute__((ext_vector_type(4)));

__device__ __forceinline__ unsigned f2bf(float f) { unsigned u = __builtin_bit_cast(unsigned, f); return (u + 0x7fffu + ((u >> 16) & 1u)) >> 16; }
__device__ __forceinline__ unsigned pk2(float lo, float hi) { return f2bf(lo) | (f2bf(hi) << 16); }
__device__ __forceinline__ float bf2f(unsigned short h) { return __builtin_bit_cast(float, (unsigned)h << 16); }
__device__ __forceinline__ float silu_f(float x) { return x / (1.0f + __expf(-x)); }
__device__ __forceinline__ float softplus_f(float x) { return fmaxf(x, 0.f) + log1pf(__expf(-fabsf(x))); }
__device__ __forceinline__ float wave_sum(float v) {
#pragma unroll
    for (int o = 1; o < 64; o <<= 1) v += __shfl_xor(v, o);
    return v;
}

constexpr size_t MiB = 1u << 20;
constexpr size_t WS_CTL = 0;
constexpr size_t WS_WIN = 1 * MiB;
constexpr size_t WS_WOUT = 13 * MiB;
constexpr size_t WS_WDT = 17 * MiB;
constexpr size_t WS_DT = 18 * MiB;
constexpr size_t WS_DACS = 19 * MiB;
constexpr size_t WS_VSTAT = 20 * MiB;
constexpr size_t WS_PROJ = 21 * MiB;
constexpr size_t WS_XC = 213 * MiB;
constexpr size_t WS_H = WS_XC;
constexpr size_t WS_ST = 277 * MiB;
constexpr size_t WS_MIXED = WS_ST;
constexpr size_t WS_END = 341 * MiB;


#define LAS __attribute__((address_space(3)))

__device__ __forceinline__ void transpose_item(const float* W, int K, int ldw, int nblk, const float* scale, bf16* WT, float* scr, int item, int lane) {
    const int kb = item / nblk, nb = item % nblk, k0 = 64 * kb, n0 = 32 * nb;
#pragma unroll 8
    for (int i = 0; i < 32; ++i) { const int kk = 2 * i + (lane >> 5); scr[kk * 33 + (lane & 31)] = W[(size_t)(k0 + kk) * ldw + n0 + (lane & 31)] * scale[k0 + kk]; }
    __builtin_amdgcn_wave_barrier(); asm volatile("s_waitcnt lgkmcnt(0)" ::: "memory");
    const int c = lane & 7;
#pragma unroll
    for (int j = 0; j < 4; ++j) { const int n = (lane >> 3) + 8 * j; const float* s = scr + (8 * c) * 33 + n;
        v4u o; o.x = pk2(s[0 * 33], s[1 * 33]); o.y = pk2(s[2 * 33], s[3 * 33]); o.z = pk2(s[4 * 33], s[5 * 33]); o.w = pk2(s[6 * 33], s[7 * 33]);
        *(v4u*)(WT + (size_t)(n0 + n) * K + k0 + 8 * c) = o; }
    __builtin_amdgcn_wave_barrier(); asm volatile("s_waitcnt lgkmcnt(0)" ::: "memory");
}

__global__ void __launch_bounds__(256) k_prep_w(const float* w_in, const float* pre_w, const float* w_out, const float* gnw, const float* snw, bf16* win_t, bf16* wout_t, float* wdt) {
    __shared__ float scr_all[4][64 * 33];
    const int wave = threadIdx.x >> 6, lane = threadIdx.x & 63;
    float* scr = scr_all[wave];
    const int gw = blockIdx.x * 4 + wave, NGW = gridDim.x * 4;
    constexpr int I_IN = (DM / 64) * (NPROJ / 32);
    constexpr int I_OUT_A = (1024 / 64) * (DM / 32);
    for (int it = gw; it < I_IN + 2 * I_OUT_A; it += NGW) {
        if (it < I_IN) transpose_item(w_in, DM, INCOLS, NPROJ / 32, pre_w, win_t, scr, it, lane);
        else if (it < I_IN + I_OUT_A) transpose_item(w_out, 2048, DM, DM / 32, gnw, wout_t, scr, it - I_IN, lane);
        else {
            const int r = it - I_IN - I_OUT_A;
            transpose_item(w_out + (size_t)1024 * DM, 2048, DM, DM / 32, snw, wout_t + 1024, scr, r, lane);
        }
    }
    for (int i = blockIdx.x * 256 + threadIdx.x; i < 16 * DM; i += gridDim.x * 256) { const int j = i / DM, k = i % DM; wdt[i] = w_in[(size_t)k * INCOLS + NPROJ + j] * pre_w[k]; }
}

__device__ __forceinline__ void rms_row_to_bf16(const float* xrow, bf16* orow, int lane) {
    const f32x4* xr = (const f32x4*)xrow + lane;
    f32x4 v[4]; float s = 0.f;
#pragma unroll
    for (int j = 0; j < 4; ++j) { v[j] = xr[64 * j]; s += (v[j].x * v[j].x + v[j].y * v[j].y) + (v[j].z * v[j].z + v[j].w * v[j].w); }
    const float rstd = rsqrtf(wave_sum(s) * (1.f / DM) + EPS);
    unsigned long long* o8 = (unsigned long long*)orow + lane;
#pragma unroll
    for (int j = 0; j < 4; ++j) o8[64 * j] = (unsigned long long)pk2(v[j].x * rstd, v[j].y * rstd) | ((unsigned long long)pk2(v[j].z * rstd, v[j].w * rstd) << 32);
}
__global__ void __launch_bounds__(256) k_h0(const float* x, bf16* h) {
    const int gw = blockIdx.x * 4 + (threadIdx.x >> 6), NGW = gridDim.x * 4, lane = threadIdx.x & 63;
    for (int m = gw; m < M_TOK; m += NGW) rms_row_to_bf16(x + (size_t)m * DM, h + (size_t)m * DM, lane);
}

constexpr int GEMM_LDS = 147456;
__global__ void __launch_bounds__(512, 2) k_gemm_in(const bf16* h, const bf16* win_t, bf16* proj) {
    extern __shared__ __attribute__((aligned(16))) unsigned char lds[];
    pg8::Gemm g{h, win_t, M_TOK, NPROJ, DM, DM}; pg8::StaticOrder S; S.init(M_TOK, NPROJ, (int)gridDim.x, (int)blockIdx.x);
    pg8::EpiBf16<0> E{proj, NPROJ, nullptr, 0, 0, 1.f};
    pg8::gemm_phase<pg8::EpiBf16<0>, pg8::StaticOrder, true, true>((PG8_LAS unsigned char*)lds, g, S, E);
}
__global__ void __launch_bounds__(512, 2) k_gemm_out(const bf16* proj, const bf16* wout_t, float* mixed) {
    extern __shared__ __attribute__((aligned(16))) unsigned char lds[];
    pg8::Gemm g{proj, wout_t, M_TOK, DM, 2048, NPROJ}; pg8::StaticOrder S; S.init(M_TOK, DM, (int)gridDim.x, (int)blockIdx.x);
    pg8::EpiF32 E{mixed, DM, nullptr};
    pg8::gemm_phase<pg8::EpiF32, pg8::StaticOrder, true, true>((PG8_LAS unsigned char*)lds, g, S, E);
}

__global__ void __launch_bounds__(256) k_dt(const bf16* h, const float* wdt, const float* dt_bias, float* dt) {
    const int gw = blockIdx.x * 4 + (threadIdx.x >> 6), NGW = gridDim.x * 4, lane = threadIdx.x & 63;
    for (int m = gw; m < M_TOK; m += NGW) {
        float hv[16];
        const bf16* hr = h + (size_t)m * DM + lane * 16;
#pragma unroll
        for (int i = 0; i < 16; ++i) hv[i] = bf2f(hr[i]);
        float mine = 0.f;
        for (int j = 0; j < 16; ++j) {
            const float* wr = wdt + (size_t)j * DM + lane * 16; float a = 0.f;
#pragma unroll
            for (int i = 0; i < 16; ++i) a += hv[i] * wr[i];
            a = wave_sum(a);
            if (lane == j) mine = a;
        }
        if (lane < 16) dt[(size_t)m * 16 + lane] = softplus_f(mine + dt_bias[lane]);
    }
}
__global__ void __launch_bounds__(256) k_dacs(const float* dt, const float* a_log, float* dacs) {
    const int i = blockIdx.x * 256 + threadIdx.x;
    if (i >= NBATCH * NCH * 16) return;
    const int h = i & 15, bc = i >> 4; const float a = -__expf(a_log[h]);
    float cs = 0.f;
    for (int l = 0; l < CH; ++l) { const size_t m = (size_t)bc * CH + l; cs += dt[m * 16 + h] * a; dacs[m * 16 + h] = cs; }
}
__global__ void __launch_bounds__(256) k_vstat(const bf16* proj, float* vstat) {
    const int gw = blockIdx.x * 4 + (threadIdx.x >> 6), NGW = gridDim.x * 4, lane = threadIdx.x & 63;
    for (int m = gw; m < M_TOK; m += NGW) {
        const bf16* vr = proj + (size_t)m * NPROJ + OFF_V + lane * 16; float v[16]; float s = 0.f;
#pragma unroll
        for (int i = 0; i < 16; ++i) { v[i] = bf2f(vr[i]); s += v[i]; }
        const float mean = wave_sum(s) * (1.f / 1024.f); float q = 0.f;
#pragma unroll
        for (int i = 0; i < 16; ++i) { const float d = v[i] - mean; q += d * d; }
        const float rstd = rsqrtf(wave_sum(q) * (1.f / 1024.f) + EPS);
        if (lane == 0) { vstat[(size_t)m * 2] = mean; vstat[(size_t)m * 2 + 1] = rstd; }
    }
}
__global__ void __launch_bounds__(256) k_gmlp(bf16* proj, const float* vstat, const float* vnw, const float* vnb, const float* ws, const float* bs) {
    extern __shared__ __attribute__((aligned(16))) unsigned char lds[];
    float* vn = (float*)lds;
    float* yt = vn + 128 * 128;
    const int head = blockIdx.x & 7, bc = blockIdx.x >> 3, tid = threadIdx.x;
    const size_t m0 = (size_t)bc * CH;
    for (int i = tid; i < 128 * 128; i += 256) { const int s = i >> 7, d = i & 127; const size_t m = m0 + s;
        const float v = bf2f(proj[m * NPROJ + OFF_V + head * 128 + d]);
        vn[i] = (v - vstat[m * 2]) * vstat[m * 2 + 1] * vnw[head * 128 + d] + vnb[head * 128 + d]; }
    __syncthreads();
    const int d = tid & 127, th = tid >> 7;
    for (int i = 0; i < 64; ++i) { const int t = 2 * i + th; const float* wr = ws + ((size_t)head * 128 + t) * 128; float acc = 0.f;
        for (int s = 0; s <= t; ++s) acc += wr[s] * vn[s * 128 + d];
        acc += bs[head * 128 + t];
        const size_t m = m0 + t; const float u = bf2f(proj[m * NPROJ + OFF_U + head * 128 + d]), zg = bf2f(proj[m * NPROJ + OFF_ZG + head * 128 + d]);
        yt[t * 129 + d] = u * acc * silu_f(zg); }
    __syncthreads();
    const int t2 = tid >> 1, half = tid & 1; float ss = 0.f;
    for (int i = 0; i < 64; ++i) { const float y = yt[t2 * 129 + half * 64 + i]; ss += y * y; }
    ss += __shfl_xor(ss, 1);
    const float rstd = rsqrtf(ss * (1.f / 128.f) + EPS);
    bf16* o = proj + (m0 + t2) * NPROJ + OFF_U + head * 128 + half * 64;
    for (int i = 0; i < 64; ++i) o[i] = (bf16)f2bf(yt[t2 * 129 + half * 64 + i] * rstd);
}
__global__ void __launch_bounds__(256) k_conv(const bf16* proj, const float* cw, const float* cb, bf16* xc) {
    const size_t i = (size_t)blockIdx.x * 256 + threadIdx.x;
    const int ch = (int)(i & 2047); const size_t m = i >> 11; const int t = (int)(m & (SEQ - 1));
    float a = cb[ch];
#pragma unroll
    for (int j = 0; j < 4; ++j) { const int tt = t - 3 + j; if (tt >= 0) a += cw[j * 2048 + ch] * bf2f(proj[(m - 3 + j) * NPROJ + OFF_XBC + ch]); }
    xc[i] = (bf16)f2bf(silu_f(a));
}
__global__ void __launch_bounds__(256) k_states(const bf16* xc, const float* dt, const float* dacs, float* st) {
    extern __shared__ __attribute__((aligned(16))) unsigned char lds[];
    float* Bs = (float*)lds;
    float* xw = Bs + 128 * 128;
    const int h = blockIdx.x & 15, bc = blockIdx.x >> 4, g = h >> 2, tid = threadIdx.x;
    const size_t m0 = (size_t)bc * CH;
    const float cs_end = dacs[(m0 + 127) * 16 + h];
    for (int i = tid; i < 128 * 128; i += 256) { const int l = i >> 7, n = i & 127; Bs[i] = bf2f(xc[(m0 + l) * 2048 + XC_B + g * 128 + n]); }
    for (int i = tid; i < 128 * 64; i += 256) { const int l = i >> 6, p = i & 63; const size_t m = m0 + l;
        xw[i] = bf2f(xc[m * 2048 + XC_X + h * 64 + p]) * dt[m * 16 + h] * __expf(cs_end - dacs[m * 16 + h]); }
    __syncthreads();
    const int n = tid & 127, ph = tid >> 7;
    float acc[32];
#pragma unroll
    for (int i = 0; i < 32; ++i) acc[i] = 0.f;
    for (int l = 0; l < 128; ++l) { const float b = Bs[l * 128 + n];
#pragma unroll
        for (int i = 0; i < 32; ++i) acc[i] += xw[l * 64 + ph * 32 + i] * b; }
    float* o = st + ((size_t)blockIdx.x * 64 + ph * 32) * 128 + n;
#pragma unroll
    for (int i = 0; i < 32; ++i) o[(size_t)i * 128] = acc[i];
}
__global__ void __launch_bounds__(256) k_scan(float* st, const float* dacs) {
    const int i = blockIdx.x * 256 + threadIdx.x;
    const int e = i & 8191, bh = i >> 13, h = bh & 15, b = bh >> 4;
    float run = 0.f;
    for (int c = 0; c < NCH; ++c) { const size_t idx = ((size_t)((b * 16 + c) * 16 + h)) * 8192 + e; const float s = st[idx];
        const float dec = __expf(dacs[((size_t)(b * SEQ + c * CH + 127)) * 16 + h]);
        st[idx] = run; run = run * dec + s; }
}
__global__ void __launch_bounds__(512) k_ssd_out(bf16* proj, const bf16* xc, const float* dt, const float* dacs, const float* st, const float* dskip) {
    extern __shared__ __attribute__((aligned(16))) unsigned char lds[];
    float* CB = (float*)lds;
    bf16* CsT = (bf16*)(lds + 66048);
    unsigned char* R2 = lds + 66048 + 32768;
    bf16* Bs = (bf16*)R2; float* xh = (float*)R2;
    float* cs = (float*)(R2 + 32768);
    float* dts = cs + 128;
    float* rowss = dts + 128;
    const int g = blockIdx.x & 3, bc = blockIdx.x >> 2, tid = threadIdx.x;
    const size_t m0 = (size_t)bc * CH;
    for (int i = tid; i < 128 * 128; i += 512) { const int l = i >> 7, n = i & 127;
        CsT[n * 128 + l] = xc[(m0 + l) * 2048 + XC_C + g * 128 + n]; Bs[i] = xc[(m0 + l) * 2048 + XC_B + g * 128 + n]; }
    if (tid < 128) rowss[tid] = 0.f;
    __syncthreads();
    const int l = tid & 127, q = tid >> 7;
    {
        float acc[32];
#pragma unroll
        for (int i = 0; i < 32; ++i) acc[i] = 0.f;
        for (int n = 0; n < 128; ++n) { const float c = bf2f(CsT[n * 128 + l]);
#pragma unroll
            for (int i = 0; i < 32; ++i) acc[i] += c * bf2f(Bs[(q * 32 + i) * 128 + n]); }
#pragma unroll
        for (int i = 0; i < 32; ++i) CB[l * 129 + q * 32 + i] = acc[i];
    }
    __syncthreads();
    float yv[4][16]; float ss = 0.f;
    const size_t m = m0 + l;
#pragma unroll
    for (int r = 0; r < 4; ++r) {
        const int h = g * 4 + r;
        for (int i = tid; i < 128 * 64; i += 512) { const int s = i >> 6, p = i & 63; xh[i] = bf2f(xc[(m0 + s) * 2048 + XC_X + h * 64 + p]); }
        if (tid < 128) { cs[tid] = dacs[(m0 + tid) * 16 + h]; dts[tid] = dt[(m0 + tid) * 16 + h]; }
        __syncthreads();
        float acc[16];
#pragma unroll
        for (int i = 0; i < 16; ++i) acc[i] = 0.f;
        const float csl = cs[l];
        {
            const float* pv = st + ((size_t)(bc * 16 + h) * 64 + q * 16) * 128;
            for (int n = 0; n < 128; ++n) { const float c = bf2f(CsT[n * 128 + l]);
#pragma unroll
                for (int i = 0; i < 16; ++i) acc[i] += c * pv[i * 128 + n]; }
            const float el0 = __expf(csl);
#pragma unroll
            for (int i = 0; i < 16; ++i) acc[i] *= el0;
        }
        for (int s = 0; s < 128; ++s) {
            const float e = __expf(fminf(csl - cs[s], 0.f));
            const float coef = (s <= l) ? CB[l * 129 + s] * e * dts[s] : 0.f;
#pragma unroll
            for (int i = 0; i < 16; ++i) acc[i] += coef * xh[s * 64 + q * 16 + i];
        }
        const float dsk = dskip[h];
#pragma unroll
        for (int i = 0; i < 16; ++i) {
            const float y = acc[i] + dsk * xh[l * 64 + q * 16 + i];
            const float z = bf2f(proj[m * NPROJ + OFF_Z + h * 64 + q * 16 + i]);
            const float gy = y * silu_f(z); yv[r][i] = gy; ss += gy * gy; }
        __syncthreads();
    }
    atomicAdd(&rowss[l], ss);
    __syncthreads();
    const float rstd = rsqrtf(rowss[l] * (1.f / 256.f) + EPS);
#pragma unroll
    for (int r = 0; r < 4; ++r) { bf16* o = proj + m * NPROJ + OFF_V + g * 256 + r * 64 + q * 16;
#pragma unroll
        for (int i = 0; i < 16; ++i) o[i] = (bf16)f2bf(yv[r][i] * rstd); }
}
__global__ void __launch_bounds__(256) k_post(const float* xin, const float* mixed, const float* post_w, float* out, bf16* h) {
    const int gw = blockIdx.x * 4 + (threadIdx.x >> 6), NGW = gridDim.x * 4, lane = threadIdx.x & 63;
    for (int m = gw; m < M_TOK; m += NGW) {
        const f32x4* mr = (const f32x4*)(mixed + (size_t)m * DM) + lane; const f32x4* xr = (const f32x4*)(xin + (size_t)m * DM) + lane; const f32x4* pw = (const f32x4*)post_w + lane;
        f32x4 v[4]; float s = 0.f;
#pragma unroll
        for (int j = 0; j < 4; ++j) { v[j] = mr[64 * j]; s += (v[j].x * v[j].x + v[j].y * v[j].y) + (v[j].z * v[j].z + v[j].w * v[j].w); }
        const float rstd = rsqrtf(wave_sum(s) * (1.f / DM) + EPS); float s2 = 0.f;
#pragma unroll
        for (int j = 0; j < 4; ++j) { v[j] = xr[64 * j] + v[j] * rstd * pw[64 * j]; s2 += (v[j].x * v[j].x + v[j].y * v[j].y) + (v[j].z * v[j].z + v[j].w * v[j].w); }
        f32x4* orow = (f32x4*)(out + (size_t)m * DM) + lane;
#pragma unroll
        for (int j = 0; j < 4; ++j) orow[64 * j] = v[j];
        const float rstd2 = rsqrtf(wave_sum(s2) * (1.f / DM) + EPS);
        unsigned long long* o8 = (unsigned long long*)(h + (size_t)m * DM) + lane;
#pragma unroll
        for (int j = 0; j < 4; ++j) o8[64 * j] = (unsigned long long)pk2(v[j].x * rstd2, v[j].y * rstd2) | ((unsigned long long)pk2(v[j].z * rstd2, v[j].w * rstd2) << 32);
    }
}

extern "C" void kernel_launch(void* const* d_in, const int* in_sizes, int n_in, void* d_out, int out_size, void* d_ws, size_t ws_size, hipStream_t stream) {
    if (n_in != 16 || ws_size < WS_END || out_size != M_TOK * DM) { fprintf(stderr, "kernel_launch: unexpected arguments (n_in %d, ws %zu, out %d)\n", n_in, ws_size, out_size); return; }
    const float* x = (const float*)d_in[0]; const float* pre_w = (const float*)d_in[1]; const float* w_in = (const float*)d_in[2];
    const float* vnw = (const float*)d_in[3]; const float* vnb = (const float*)d_in[4]; const float* gws = (const float*)d_in[5]; const float* gbs = (const float*)d_in[6];
    const float* gnw = (const float*)d_in[7]; const float* cw = (const float*)d_in[8]; const float* cb = (const float*)d_in[9]; const float* dtb = (const float*)d_in[10];
    const float* alog = (const float*)d_in[11]; const float* dsk = (const float*)d_in[12]; const float* snw = (const float*)d_in[13]; const float* w_out = (const float*)d_in[14];
    const float* post_w = (const float*)d_in[15];
    unsigned char* ws = (unsigned char*)d_ws; float* out = (float*)d_out;
    bf16* win_t = (bf16*)(ws + WS_WIN); bf16* wout_t = (bf16*)(ws + WS_WOUT); float* wdt = (float*)(ws + WS_WDT); float* dt = (float*)(ws + WS_DT); float* dacs = (float*)(ws + WS_DACS);
    float* vstat = (float*)(ws + WS_VSTAT); bf16* proj = (bf16*)(ws + WS_PROJ); bf16* xc = (bf16*)(ws + WS_XC); bf16* h = (bf16*)(ws + WS_H); float* st = (float*)(ws + WS_ST); float* mixed = (float*)(ws + WS_MIXED);
    static bool attr_done = false;
    if (!attr_done) {
        (void)hipFuncSetAttribute((const void*)k_gemm_in, hipFuncAttributeMaxDynamicSharedMemorySize, GEMM_LDS);
        (void)hipFuncSetAttribute((const void*)k_gemm_out, hipFuncAttributeMaxDynamicSharedMemorySize, GEMM_LDS);
        (void)hipFuncSetAttribute((const void*)k_gmlp, hipFuncAttributeMaxDynamicSharedMemorySize, 131584);
        (void)hipFuncSetAttribute((const void*)k_states, hipFuncAttributeMaxDynamicSharedMemorySize, 98304);
        (void)hipFuncSetAttribute((const void*)k_ssd_out, hipFuncAttributeMaxDynamicSharedMemorySize, 133120);
        attr_done = true;
    }
    k_h0<<<1024, 256, 0, stream>>>(x, h);
    for (int l = 0; l < DEPTH; ++l) {
        k_prep_w<<<1024, 256, 0, stream>>>(w_in + (size_t)l * DM * INCOLS, pre_w + l * DM, w_out + (size_t)l * 2048 * DM, gnw + l * 1024, snw + l * 1024, win_t, wout_t, wdt);
        k_gemm_in<<<256, 512, GEMM_LDS, stream>>>(h, win_t, proj);
        k_dt<<<1024, 256, 0, stream>>>(h, wdt, dtb + l * 16, dt);
        k_dacs<<<8, 256, 0, stream>>>(dt, alog + l * 16, dacs);
        k_vstat<<<1024, 256, 0, stream>>>(proj, vstat);
        k_gmlp<<<NBATCH * NCH * 8, 256, 131584, stream>>>(proj, vstat, vnw + l * 1024, vnb + l * 1024, gws + (size_t)l * 8 * 128 * 128, gbs + l * 8 * 128);
        k_conv<<<M_TOK * 2048 / 256, 256, 0, stream>>>(proj, cw + (size_t)l * 4 * 2048, cb + l * 2048, xc);
        k_states<<<NBATCH * NCH * 16, 256, 98304, stream>>>(xc, dt, dacs, st);
        k_scan<<<NBATCH * 16 * 8192 / 256, 256, 0, stream>>>(st, dacs);
        k_ssd_out<<<NBATCH * NCH * 4, 512, 133120, stream>>>(proj, xc, dt, dacs, st, dsk + l * 16);
        k_gemm_out<<<256, 512, GEMM_LDS, stream>>>(proj, wout_t, mixed);
        k_post<<<1024, 256, 0, stream>>>(l == 0 ? x : out, mixed, post_w + l * DM, out, h);
    }
}
```

```cpp
#include <hip/hip_runtime.h>
#include <cstdio>
#include <cstdint>
namespace pg8 {
#define PG8_LAS __attribute__((address_space(3)))
typedef unsigned short bf16_t;
typedef short bf16x8 __attribute__((ext_vector_type(8)));
typedef float f32x4 __attribute__((ext_vector_type(4)));
typedef unsigned u32x4 __attribute__((ext_vector_type(4)));
constexpr int BM = 256, BK = 64, HALF = 128, HTB = HALF * BK * 2  , STAGE_BYTES = 8 * HTB, NXCD = 8, WGM = 8;

__host__ __device__ __forceinline__ int lds_byte(int r, int c) { const int st = (r >> 4) * 2 + (c >> 5), rr = r & 15, cc = c & 31, ob = rr * 64 + cc * 2; return st * 1024 + (ob ^ (((ob >> 9) & 1) << 5)); }
__host__ __device__ __forceinline__ void stage_rc(int b, int& R, int& C) { const int st = b / 1024, sb = b % 1024, swz = sb ^ (((sb >> 9) & 1) << 5); R = (st >> 1) * 16 + swz / 64; C = (st & 1) * 32 + (swz % 64) / 2; }
__host__ __device__ __forceinline__ int perm32(int rho) { const int n = rho >> 4, i = rho & 15; return 8 * (i >> 2) + 4 * n + (i & 3); }

struct Unit { int pm, pn; };
struct Gemm { const bf16_t* A; const bf16_t* Bt; int M, N, K, lda; };

struct StaticOrder {
    int nM, nN, nwg, G, c;
    __host__ __device__ void init(int M, int N, int G_, int c_) { nM = M / BM; nN = N / BM; nwg = nM * nN; G = G_; c = c_; }
    __host__ __device__ bool next(int i, Unit& u) const {
        const long L = (long)i * G + c; if (L >= nwg) return false;
        int wgid = (int)L; { const int q = nwg / NXCD, r = nwg % NXCD, xcd = wgid % NXCD, off = wgid / NXCD; wgid = (xcd < r ? xcd * (q + 1) : r * (q + 1) + (xcd - r) * q) + off; }
        const int nig = WGM * nN, gid = wgid / nig, fm = gid * WGM, gsz = (nM - fm) < WGM ? (nM - fm) : WGM;
        u.pm = fm + ((wgid % nig) % gsz); u.pn = (wgid % nig) / gsz; return true;
    }
    __device__ __forceinline__ void a_ready(const Unit&) const {}
    __device__ __forceinline__ void done(const Unit&) const {}
};

__device__ __forceinline__ unsigned cvt_pk_bf16(float lo, float hi) { unsigned r; asm volatile("v_cvt_pk_bf16_f32 %0, %1, %2" : "=v"(r) : "v"(lo), "v"(hi)); return r; }
typedef float f32x2 __attribute__((ext_vector_type(2)));
__device__ __forceinline__ f32x2 gelu_pk(f32x2 v) {
    const f32x2 av = __builtin_elementwise_abs(v), d = av * 0.2316418882f + 1.0f;
    f32x2 t; t.x = __builtin_amdgcn_rcpf(d.x); t.y = __builtin_amdgcn_rcpf(d.y);
    f32x2 q = t * 0.5307027145f + (-0.7265760135f); q = q * t + 0.7107068705f; q = q * t + (-0.142248368f); q = q * t + 0.127414796f; q = q * t;
    const f32x2 s = (v * v) * (-0.72134752044f);
    f32x2 e; e.x = __builtin_amdgcn_exp2f(s.x); e.y = __builtin_amdgcn_exp2f(s.y);
    const f32x2 m = v * (q * e), r = v - m;
    f32x2 o; o.x = v.x < 0.f ? m.x : r.x; o.y = v.y < 0.f ? m.y : r.y; return o;
}

template <int ACT  > struct EpiBf16 {
    static constexpr bool PERM = true, AFTER_DRAIN = false; static_assert(ACT == 0 || ACT == 1, "EpiBf16: ACT is 0 (none) or 1 (gelu_pk)");
    bf16_t* O; int ldc; const float* bias; int split_cols; size_t split_stride; float scale0;
    __device__ __forceinline__ void operator()(const f32x4 (&acc)[2][2][4][2], const Unit& u, int wr, int wc, int fr, int fq) const {
        const int row0 = u.pm * BM + wr * 64 + fr; int colt = u.pn * BM; bf16_t* base = O;
        float sc = 1.f; if (split_cols) { const int t = colt / split_cols; base += (size_t)t * split_stride; colt -= t * split_cols; if (t == 0) sc = scale0; }
        const int col0 = colt + wc * 32 + 8 * fq, bcol0 = u.pn * BM + wc * 32 + 8 * fq;
        f32x4 bv[2][2];
#pragma unroll
        for (int bj = 0; bj < 2; ++bj)
#pragma unroll
            for (int n = 0; n < 2; ++n) bv[bj][n] = bias ? *(const f32x4*)(bias + bcol0 + bj * HALF + 4 * n) : (f32x4){0.f, 0.f, 0.f, 0.f};
#pragma unroll
        for (int ai = 0; ai < 2; ++ai)
#pragma unroll
            for (int m = 0; m < 4; ++m) { bf16_t* rowp = base + (size_t)(row0 + ai * HALF + m * 16) * ldc + col0;
#pragma unroll
                for (int bj = 0; bj < 2; ++bj) { f32x4 v0 = acc[ai][bj][m][0] + bv[bj][0], v1 = acc[ai][bj][m][1] + bv[bj][1];
                    if (ACT == 1) { f32x2 a = gelu_pk((f32x2){v0[0], v0[1]}), b = gelu_pk((f32x2){v0[2], v0[3]}), c = gelu_pk((f32x2){v1[0], v1[1]}), d = gelu_pk((f32x2){v1[2], v1[3]});
                        v0 = (f32x4){a.x, a.y, b.x, b.y}; v1 = (f32x4){c.x, c.y, d.x, d.y}; }
                    v0 = v0 * sc; v1 = v1 * sc; u32x4 w; w.x = cvt_pk_bf16(v0[0], v0[1]); w.y = cvt_pk_bf16(v0[2], v0[3]); w.z = cvt_pk_bf16(v1[0], v1[1]); w.w = cvt_pk_bf16(v1[2], v1[3]);
                    *(u32x4*)(rowp + bj * HALF) = w; } }
    }
};
struct EpiF32 {
    static constexpr bool PERM = false, AFTER_DRAIN = false;
    float* C; int ldc; const float* bias;
    __device__ __forceinline__ void operator()(const f32x4 (&acc)[2][2][4][2], const Unit& u, int wr, int wc, int fr, int fq) const {
        const int row0 = u.pm * BM + wr * 64 + fr, col0 = u.pn * BM + wc * 32 + 4 * fq;
        f32x4 bv[2][2];
#pragma unroll
        for (int bj = 0; bj < 2; ++bj)
#pragma unroll
            for (int n = 0; n < 2; ++n) bv[bj][n] = bias ? *(const f32x4*)(bias + col0 + bj * HALF + n * 16) : (f32x4){0.f, 0.f, 0.f, 0.f};
#pragma unroll
        for (int ai = 0; ai < 2; ++ai)
#pragma unroll
            for (int m = 0; m < 4; ++m) { float* rowp = C + (size_t)(row0 + ai * HALF + m * 16) * ldc + col0;
#pragma unroll
                for (int bj = 0; bj < 2; ++bj)
#pragma unroll
                    for (int n = 0; n < 2; ++n) *(f32x4*)(rowp + bj * HALF + n * 16) = acc[ai][bj][m][n] + bv[bj][n]; }
    }
};
template <class Epi, class Sched, bool ALIGN_EPI = false, bool SP2 = false>
__device__ __forceinline__ void gemm_phase(PG8_LAS unsigned char* lds, const Gemm g, const Sched& S, const Epi& E) {
    int tid_ = threadIdx.x; asm volatile("" : "+v"(tid_));
    const int tid = tid_, wid = __builtin_amdgcn_readfirstlane(tid >> 6), lane = tid & 63, wr = wid >> 2, wc = wid & 3, fr = lane & 15, fq = lane >> 4;
    const int K = g.K, nt = K / BK;
    unsigned voffA[2], voffB[2];
#pragma unroll
    for (int i = 0; i < 2; ++i) { int R, C; stage_rc(tid * 16 + i * 8192, R, C); const int Rb = Epi::PERM ? ((R & ~31) + perm32(R & 31)) : R;
        voffA[i] = (unsigned)(R * g.lda + C) * 2u; voffB[i] = (unsigned)(Rb * K + C) * 2u; }
    const size_t kstep = (size_t)(BK * 2);
    const size_t hstepA = (size_t)HALF * g.lda * 2, hstepB = (size_t)HALF * K * 2;
    const size_t tstepA = 2 * hstepA, tstepB = 2 * hstepB;
    const unsigned ldsw = (unsigned)wid * 1024u;
    const int aoff = lds_byte(wr * 64 + fr, fq * 8), boff = lds_byte(wc * 32 + fr, fq * 8);
#define PG8_SA(b, h) (((b) * 2 + (h)) * HTB)
#define PG8_SB(b, h) ((4 + (b) * 2 + (h)) * HTB)
#define PG8_STAGE(bufoff, gbase, voff) do { _Pragma("unroll") for (int _i = 0; _i < 2; ++_i) \
        __builtin_amdgcn_global_load_lds((const unsigned*)((const char*)(gbase) + (voff)[_i]), (PG8_LAS unsigned*)(lds + (bufoff) + ldsw + _i * 8192), 16, 0, 0); } while (0)
#define PG8_LDA(dst, b, h) do { _Pragma("unroll") for (int m = 0; m < 4; ++m) _Pragma("unroll") for (int k = 0; k < 2; ++k) dst[m][k] = *(const PG8_LAS bf16x8*)(lds + PG8_SA(b, h) + aoff + m * 2048 + k * 1024); } while (0)
#define PG8_LDB(dst, b, h) do { _Pragma("unroll") for (int n = 0; n < 2; ++n) _Pragma("unroll") for (int k = 0; k < 2; ++k) dst[n][k] = *(const PG8_LAS bf16x8*)(lds + PG8_SB(b, h) + boff + n * 2048 + k * 1024); } while (0)
#define PG8_MMA(ai, bj, At, Bt) do { __builtin_amdgcn_s_setprio(1); _Pragma("unroll") for (int m = 0; m < 4; ++m) _Pragma("unroll") for (int n = 0; n < 2; ++n) _Pragma("unroll") for (int k = 0; k < 2; ++k) \
        acc[ai][bj][m][n] = __builtin_amdgcn_mfma_f32_16x16x32_bf16(Bt[n][k], At[m][k], acc[ai][bj][m][n], 0, 0, 0); __builtin_amdgcn_s_setprio(0); } while (0)
#define PG8_WAIT_V(n) asm volatile("s_waitcnt vmcnt(" #n ")" ::: "memory")
#define PG8_WAIT_L(n) asm volatile("s_waitcnt lgkmcnt(" #n ")" ::: "memory")
#define PG8_BAR __builtin_amdgcn_s_barrier()
#define PG8_SCHED __builtin_amdgcn_sched_barrier(0)
    Unit cur, nxt; int ui = 0;
    if (!S.next(0, cur)) return;
    f32x4 acc[2][2][4][2];
#pragma unroll
    for (int a = 0; a < 2; ++a)
#pragma unroll
        for (int b = 0; b < 2; ++b)
#pragma unroll
            for (int m = 0; m < 4; ++m)
#pragma unroll
                for (int n = 0; n < 2; ++n) acc[a][b][m][n] = (f32x4){0.f, 0.f, 0.f, 0.f};
    bf16x8 At[4][2], B0[2][2], B1[2][2];
    const char* cA = (const char*)g.A + (size_t)cur.pm * tstepA; const char* cB = (const char*)g.Bt + (size_t)cur.pn * tstepB;
    S.a_ready(cur);
    if constexpr (SP2) {
        PG8_STAGE(PG8_SB(0, 0), cB, voffB); PG8_STAGE(PG8_SB(0, 1), cB + hstepB, voffB); PG8_STAGE(PG8_SA(0, 0), cA, voffA); PG8_STAGE(PG8_SA(0, 1), cA + hstepA, voffA);
        if (wr == 1) PG8_BAR;
        PG8_WAIT_V(2); PG8_BAR;
        PG8_STAGE(PG8_SB(1, 0), cB + kstep, voffB); PG8_STAGE(PG8_SA(1, 0), cA + kstep, voffA); PG8_STAGE(PG8_SB(1, 1), cB + hstepB + kstep, voffB);
        PG8_WAIT_V(6); PG8_BAR;
    } else {
        PG8_STAGE(PG8_SB(0, 0), cB, voffB); PG8_STAGE(PG8_SA(0, 0), cA, voffA); PG8_STAGE(PG8_SB(0, 1), cB + hstepB, voffB); PG8_STAGE(PG8_SA(0, 1), cA + hstepA, voffA);
        if (wr == 1) PG8_BAR;
        PG8_WAIT_V(4); PG8_BAR;
        PG8_STAGE(PG8_SB(1, 0), cB + kstep, voffB); PG8_STAGE(PG8_SA(1, 0), cA + kstep, voffA); PG8_STAGE(PG8_SB(1, 1), cB + hstepB + kstep, voffB);
        PG8_WAIT_V(6); PG8_BAR;
    }
    for (;;) {
        const bool has_next = S.next(ui + 1, nxt);
        const char* nA = has_next ? (const char*)g.A + (size_t)nxt.pm * tstepA : cA; const char* nB = has_next ? (const char*)g.Bt + (size_t)nxt.pn * tstepB : cB;
        for (int t = 0; t < nt; t += 2) {
            const bool last = (t == nt - 2);
            const char* a1 = cA + (size_t)(t + 1) * kstep;
            const char* a2 = last ? nA : cA + (size_t)(t + 2) * kstep; const char* b2 = last ? nB : cB + (size_t)(t + 2) * kstep;
            const char* a3 = a2 + kstep; const char* b3 = b2 + kstep;
            if (last && has_next) S.a_ready(nxt);
            if constexpr (SP2) {
            PG8_LDB(B0, 0, 0); PG8_LDB(B1, 0, 1); PG8_SCHED; PG8_LDA(At, 0, 0); PG8_STAGE(PG8_SA(1, 1), a1 + hstepA, voffA);
            PG8_WAIT_V(8); PG8_WAIT_L(0); PG8_BAR; PG8_MMA(0, 0, At, B0); PG8_MMA(0, 1, At, B1); PG8_BAR; PG8_SCHED;
            PG8_LDA(At, 0, 1); PG8_STAGE(PG8_SB(0, 0), b2, voffB); PG8_STAGE(PG8_SB(0, 1), b2 + hstepB, voffB); PG8_STAGE(PG8_SA(0, 0), a2, voffA);
            PG8_WAIT_V(8); PG8_WAIT_L(0); PG8_BAR; PG8_MMA(1, 0, At, B0); PG8_MMA(1, 1, At, B1); PG8_BAR; PG8_SCHED;
            PG8_LDB(B0, 1, 0); PG8_LDB(B1, 1, 1); PG8_SCHED; PG8_LDA(At, 1, 0); PG8_STAGE(PG8_SA(0, 1), a2 + hstepA, voffA);
            PG8_WAIT_V(8); PG8_WAIT_L(0); PG8_BAR; PG8_MMA(0, 0, At, B0); PG8_MMA(0, 1, At, B1); PG8_BAR; PG8_SCHED;
            PG8_LDA(At, 1, 1); PG8_STAGE(PG8_SB(1, 0), b3, voffB); PG8_STAGE(PG8_SB(1, 1), b3 + hstepB, voffB); PG8_STAGE(PG8_SA(1, 0), a3, voffA);
            PG8_WAIT_V(8); PG8_WAIT_L(0); PG8_BAR; PG8_MMA(1, 0, At, B0); PG8_MMA(1, 1, At, B1); PG8_BAR; PG8_SCHED;
            } else {
            PG8_LDB(B0, 0, 0); PG8_SCHED; PG8_LDA(At, 0, 0); PG8_STAGE(PG8_SA(1, 1), a1 + hstepA, voffA);
            PG8_WAIT_L(8); PG8_BAR; PG8_WAIT_L(0); PG8_MMA(0, 0, At, B0); PG8_BAR; PG8_SCHED;
            PG8_LDB(B1, 0, 1); PG8_STAGE(PG8_SB(0, 0), b2, voffB);
            PG8_BAR; PG8_WAIT_L(0); PG8_MMA(0, 1, At, B1); PG8_BAR;
            PG8_LDA(At, 0, 1); PG8_STAGE(PG8_SA(0, 0), a2, voffA);
            PG8_BAR; PG8_WAIT_L(0); PG8_MMA(1, 0, At, B0); PG8_BAR; PG8_SCHED;
            PG8_STAGE(PG8_SB(0, 1), b2 + hstepB, voffB);
            PG8_WAIT_V(6); PG8_BAR; PG8_MMA(1, 1, At, B1); PG8_BAR;
            PG8_LDB(B0, 1, 0); PG8_SCHED; PG8_LDA(At, 1, 0); PG8_STAGE(PG8_SA(0, 1), a2 + hstepA, voffA);
            PG8_WAIT_L(8); PG8_BAR; PG8_WAIT_L(0); PG8_MMA(0, 0, At, B0); PG8_BAR; PG8_SCHED;
            PG8_LDB(B1, 1, 1); PG8_STAGE(PG8_SB(1, 0), b3, voffB);
            PG8_BAR; PG8_WAIT_L(0); PG8_MMA(0, 1, At, B1); PG8_BAR;
            PG8_LDA(At, 1, 1); PG8_STAGE(PG8_SA(1, 0), a3, voffA);
            PG8_BAR; PG8_WAIT_L(0); PG8_MMA(1, 0, At, B0); PG8_BAR; PG8_SCHED;
            PG8_STAGE(PG8_SB(1, 1), b3 + hstepB, voffB);
            PG8_WAIT_V(6); PG8_BAR; PG8_MMA(1, 1, At, B1); PG8_BAR;
            }
        }
        if constexpr (ALIGN_EPI) { if (wr == 0) PG8_BAR; }
        if constexpr (!Epi::AFTER_DRAIN) { E(acc, cur, wr, wc, fr, fq); S.done(cur); }
        if (!has_next) break;
#pragma unroll
        for (int a = 0; a < 2; ++a)
#pragma unroll
            for (int b = 0; b < 2; ++b)
#pragma unroll
                for (int m = 0; m < 4; ++m)
#pragma unroll
                    for (int n = 0; n < 2; ++n) acc[a][b][m][n] = (f32x4){0.f, 0.f, 0.f, 0.f};
        cur = nxt; cA = nA; cB = nB; ++ui;
        if constexpr (ALIGN_EPI) { if (wr == 1) PG8_BAR; }
    }
    PG8_WAIT_V(0);
    if constexpr (!ALIGN_EPI) { if (wr == 0) PG8_BAR; }
    PG8_BAR;
    if constexpr (Epi::AFTER_DRAIN) { E.fused(acc, cur, wr, wc, fr, fq, lds, wid, lane); S.done(cur); }
#undef PG8_SA
#undef PG8_SB
#undef PG8_STAGE
#undef PG8_LDA
#undef PG8_LDB
#undef PG8_MMA
#undef PG8_WAIT_V
#undef PG8_WAIT_L
#undef PG8_BAR
#undef PG8_SCHED
}
}

constexpr int M_TOK = 16384, DM = 1024, SEQ = 2048, NBATCH = 8, NCH = 16, CH = 128, DEPTH = 4;
constexpr int NPROJ = 6144, INCOLS = 6160;
constexpr int OFF_U = 0, OFF_V = 1024, OFF_ZG = 2048, OFF_Z = 3072, OFF_XBC = 4096;
constexpr int XC_X = 0, XC_B = 1024, XC_C = 1536;
constexpr float EPS = 1e-6f;
typedef unsigned short bf16;
typedef float f32x4 __attribute__((ext_vector_type(4)));
typedef unsigned v4u __attribute__((ext_vector_type(4)));

__device__ __forceinline__ unsigned f2bf(float f) { unsigned u = __builtin_bit_cast(unsigned, f); return (u + 0x7fffu + ((u >> 16) & 1u)) >> 16; }
__device__ __forceinline__ unsigned pk2(float lo, float hi) { return f2bf(lo) | (f2bf(hi) << 16); }
__device__ __forceinline__ float bf2f(unsigned short h) { return __builtin_bit_cast(float, (unsigned)h << 16); }
__device__ __forceinline__ float silu_f(float x) { return x / (1.0f + __expf(-x)); }
__device__ __forceinline__ float softplus_f(float x) { return fmaxf(x, 0.f) + log1pf(__expf(-fabsf(x))); }
__device__ __forceinline__ float wave_sum(float v) {
#pragma unroll
    for (int o = 1; o < 64; o <<= 1) v += __shfl_xor(v, o);
    return v;
}

constexpr size_t MiB = 1u << 20;
constexpr size_t WS_CTL = 0;
constexpr size_t WS_WIN = 1 * MiB;
constexpr size_t WS_WOUT = 13 * MiB;
constexpr size_t WS_WDT = 17 * MiB;
constexpr size_t WS_DT = 18 * MiB;
constexpr size_t WS_DACS = 19 * MiB;
constexpr size_t WS_VSTAT = 20 * MiB;
constexpr size_t WS_PROJ = 21 * MiB;
constexpr size_t WS_XC = 213 * MiB;
constexpr size_t WS_H = WS_XC;
constexpr size_t WS_ST = 277 * MiB;
constexpr size_t WS_MIXED = WS_ST;
constexpr size_t WS_END = 341 * MiB;


#define LAS __attribute__((address_space(3)))

__device__ __forceinline__ void transpose_item(const float* W, int K, int ldw, int nblk, const float* scale, bf16* WT, float* scr, int item, int lane) {
    const int kb = item / nblk, nb = item % nblk, k0 = 64 * kb, n0 = 32 * nb;
#pragma unroll 8
    for (int i = 0; i < 32; ++i) { const int kk = 2 * i + (lane >> 5); scr[kk * 33 + (lane & 31)] = W[(size_t)(k0 + kk) * ldw + n0 + (lane & 31)] * scale[k0 + kk]; }
    __builtin_amdgcn_wave_barrier(); asm volatile("s_waitcnt lgkmcnt(0)" ::: "memory");
    const int c = lane & 7;
#pragma unroll
    for (int j = 0; j < 4; ++j) { const int n = (lane >> 3) + 8 * j; const float* s = scr + (8 * c) * 33 + n;
        v4u o; o.x = pk2(s[0 * 33], s[1 * 33]); o.y = pk2(s[2 * 33], s[3 * 33]); o.z = pk2(s[4 * 33], s[5 * 33]); o.w = pk2(s[6 * 33], s[7 * 33]);
        *(v4u*)(WT + (size_t)(n0 + n) * K + k0 + 8 * c) = o; }
    __builtin_amdgcn_wave_barrier(); asm volatile("s_waitcnt lgkmcnt(0)" ::: "memory");
}

__device__ __forceinline__ void rms_row_to_bf16(const float* xrow, bf16* orow, int lane) {
    const f32x4* xr = (const f32x4*)xrow + lane;
    f32x4 v[4]; float s = 0.f;
#pragma unroll
    for (int j = 0; j < 4; ++j) { v[j] = xr[64 * j]; s += (v[j].x * v[j].x + v[j].y * v[j].y) + (v[j].z * v[j].z + v[j].w * v[j].w); }
    const float rstd = rsqrtf(wave_sum(s) * (1.f / DM) + EPS);
    unsigned long long* o8 = (unsigned long long*)orow + lane;
#pragma unroll
    for (int j = 0; j < 4; ++j) o8[64 * j] = (unsigned long long)pk2(v[j].x * rstd, v[j].y * rstd) | ((unsigned long long)pk2(v[j].z * rstd, v[j].w * rstd) << 32);
}
#define XB_TMO      128
#define XB_XCNT(j)  (256  + 64 * (j))
#define XB_XSUB(j)  (1280 + 64 * (j))
#define XB_XGEN(j)  (2304 + 64 * (j))
#define XB_TOP      3328
#define XB_TOPGEN   3392
#define XCD_BAR_WORDS 3456
#define XB_SPIN_CAP (1u << 22)

__device__ __forceinline__ unsigned xb_ld(unsigned* p)              { return __hip_atomic_load(p, __ATOMIC_RELAXED, __HIP_MEMORY_SCOPE_AGENT); }
__device__ __forceinline__ unsigned xb_add(unsigned* p, unsigned v) { return __hip_atomic_fetch_add(p, v, __ATOMIC_RELAXED, __HIP_MEMORY_SCOPE_AGENT); }
__device__ __forceinline__ unsigned xb_xcc_id() { return (unsigned)__builtin_amdgcn_s_getreg((3 << 11) | 20) & 0xFu; }
#define XB_SPIN(cond, bar) do { unsigned _sp = 0; while (cond) { __builtin_amdgcn_s_sleep(1); \
    if ((++_sp & 255u) == 0u) { if (xb_ld(&(bar)[XB_TMO])) break; if (_sp > XB_SPIN_CAP) { atomicAdd(&(bar)[XB_TMO], 1u); break; } } } } while (0)

struct XcdBarrier {
    unsigned* bar; unsigned x;
    volatile LAS unsigned* st;
};

__device__ __forceinline__ XcdBarrier xcd_barrier_post(unsigned* bar, volatile LAS unsigned* st) {
    XcdBarrier b; b.bar = bar; b.x = xb_xcc_id(); b.st = st;
    if (threadIdx.x == 0) (void)xb_add(&bar[XB_XCNT(b.x)], 1u);
    return b;
}
__device__ __forceinline__ void xcd_barrier_complete(unsigned* bar, unsigned x, unsigned& nloc, unsigned& nx) {
    const unsigned G = gridDim.x * gridDim.y * gridDim.z;
    unsigned sum, cnt, mine, sp = 0u;
    for (;;) {
        sum = 0u; cnt = 0u; mine = 0u;
#pragma unroll
        for (unsigned j = 0; j < 16; ++j) { const unsigned c = xb_ld(&bar[XB_XCNT(j)]); sum += c; cnt += (c > 0u) ? 1u : 0u; mine = (j == x) ? c : mine; }
        if (sum == G) break;
        __builtin_amdgcn_s_sleep(1);
        if ((++sp & 255u) == 0u) { if (xb_ld(&bar[XB_TMO])) break; if (sp > XB_SPIN_CAP) { atomicAdd(&bar[XB_TMO], 1u); break; } }
    }
    nloc = mine > 0u ? mine : 1u; nx = cnt > 0u ? cnt : 1u;
}

__device__ __forceinline__ void xcd_barrier(const XcdBarrier& b) {
    asm volatile("s_waitcnt vmcnt(0)" ::: "memory");
    __syncthreads();
    if (threadIdx.x == 0) {
        unsigned* bar = b.bar;
        __builtin_amdgcn_s_waitcnt(0);
        unsigned nloc = b.st[0], nx = b.st[1];
        if (nloc == 0u) { xcd_barrier_complete(bar, b.x, nloc, nx); b.st[0] = nloc; b.st[1] = nx; }
        const unsigned old = xb_add(&bar[XB_XSUB(b.x)], 1u);
        const unsigned gen = old / nloc;
        if (old + 1u == (gen + 1u) * nloc) {
            __builtin_amdgcn_fence(__ATOMIC_RELEASE, "agent");
            asm volatile("s_waitcnt vmcnt(0)" ::: "memory");
            const unsigned og = xb_add(&bar[XB_TOP], 1u);
            const unsigned tg = og / nx;
            if (og + 1u == (tg + 1u) * nx) xb_add(&bar[XB_TOPGEN], 1u);
            else XB_SPIN(xb_ld(&bar[XB_TOPGEN]) == tg, bar);
            __builtin_amdgcn_fence(__ATOMIC_ACQUIRE, "agent");
            xb_add(&bar[XB_XGEN(b.x)], 1u);
            asm volatile("s_waitcnt vmcnt(0)" ::: "memory");
        } else {
            XB_SPIN(xb_ld(&bar[XB_XGEN(b.x)]) == gen, bar);
            __builtin_amdgcn_fence(__ATOMIC_ACQUIRE, "agent");
            asm volatile("s_waitcnt vmcnt(0)" ::: "memory");
        }
    }
    __syncthreads();
}

constexpr int NTHR = 512, NWAVES = 8;
constexpr int LDS_BYTES = 147456;
constexpr int LDSCTL_OFF = LDS_BYTES - 512;
constexpr int CW_BAR = 4096;

__device__ __forceinline__ void ph_prep_w(const float* w_in, const float* pre_w, const float* w_out, const float* gnw, const float* snw, bf16* win_t, bf16* wout_t, float* wdt,
                                          unsigned char* lds, int vcu, int G, int wave, int lane, int tid) {
    float* scr = (float*)(lds + wave * 8448);
    const int gw = vcu * NWAVES + wave, NGW = G * NWAVES;
    constexpr int I_IN = (DM / 64) * (NPROJ / 32);
    constexpr int I_OUT_A = (1024 / 64) * (DM / 32);
    for (int it = gw; it < I_IN + 2 * I_OUT_A; it += NGW) {
        if (it < I_IN) transpose_item(w_in, DM, INCOLS, NPROJ / 32, pre_w, win_t, scr, it, lane);
        else if (it < I_IN + I_OUT_A) transpose_item(w_out, 2048, DM, DM / 32, gnw, wout_t, scr, it - I_IN, lane);
        else transpose_item(w_out + (size_t)1024 * DM, 2048, DM, DM / 32, snw, wout_t + 1024, scr, it - I_IN - I_OUT_A, lane);
    }
    for (int i = vcu * NTHR + tid; i < 16 * DM; i += G * NTHR) { const int j = i / DM, k = i % DM; wdt[i] = w_in[(size_t)k * INCOLS + NPROJ + j] * pre_w[k]; }
}
__device__ __forceinline__ void ph_h0(const float* x, bf16* h, int vcu, int G, int wave, int lane) {
    for (int m = vcu * NWAVES + wave; m < M_TOK; m += G * NWAVES) rms_row_to_bf16(x + (size_t)m * DM, h + (size_t)m * DM, lane);
}
__device__ __forceinline__ void ph_dt(const bf16* h, const float* wdt, const float* dt_bias, float* dt, int vcu, int G, int wave, int lane) {
    for (int m = vcu * NWAVES + wave; m < M_TOK; m += G * NWAVES) {
        float hv[16];
        const bf16* hr = h + (size_t)m * DM + lane * 16;
#pragma unroll
        for (int i = 0; i < 16; ++i) hv[i] = bf2f(hr[i]);
        float mine = 0.f;
        for (int j = 0; j < 16; ++j) {
            const float* wr = wdt + (size_t)j * DM + lane * 16; float a = 0.f;
#pragma unroll
            for (int i = 0; i < 16; ++i) a += hv[i] * wr[i];
            a = wave_sum(a);
            if (lane == j) mine = a;
        }
        if (lane < 16) dt[(size_t)m * 16 + lane] = softplus_f(mine + dt_bias[lane]);
    }
}
__device__ __forceinline__ void ph_dacs(const float* dt, const float* a_log, float* dacs, int vcu, int G, int tid) {
    for (int bc = vcu; bc < NBATCH * NCH; bc += G) {
        if (tid < 16) { const int h = tid; const float a = -__expf(a_log[h]); float cs = 0.f;
            for (int l = 0; l < CH; ++l) { const size_t m = (size_t)bc * CH + l; cs += dt[m * 16 + h] * a; dacs[m * 16 + h] = cs; } }
    }
}
__device__ __forceinline__ void gmlp_unit(int unit, bf16* proj, const float* vnw, const float* vnb, const float* ws, const float* bs, unsigned char* lds, int tid, int wave, int lane) {
    float* vn = (float*)lds;
    float* yt = vn + 128 * 128;
    float* stat = yt + 128 * 129;
    const int head = unit & 7, bc = unit >> 3;
    const size_t m0 = (size_t)bc * CH;
    for (int r = 0; r < 16; ++r) { const int row = wave * 16 + r;
        const bf16* vr = proj + (m0 + row) * NPROJ + OFF_V + lane * 16; float v[16]; float s = 0.f;
#pragma unroll
        for (int i = 0; i < 16; ++i) { v[i] = bf2f(vr[i]); s += v[i]; }
        const float mean = wave_sum(s) * (1.f / 1024.f); float q = 0.f;
#pragma unroll
        for (int i = 0; i < 16; ++i) { const float d = v[i] - mean; q += d * d; }
        const float rstd = rsqrtf(wave_sum(q) * (1.f / 1024.f) + EPS);
        if (lane == 0) { stat[row * 2] = mean; stat[row * 2 + 1] = rstd; } }
    __syncthreads();
    for (int i = tid; i < 128 * 128; i += NTHR) { const int s = i >> 7, d = i & 127; const size_t m = m0 + s;
        const float v = bf2f(proj[m * NPROJ + OFF_V + head * 128 + d]);
        vn[i] = (v - stat[s * 2]) * stat[s * 2 + 1] * vnw[head * 128 + d] + vnb[head * 128 + d]; }
    __syncthreads();
    const int d = tid & 127, th = tid >> 7;
    for (int i = 0; i < 32; ++i) { const int t = 4 * i + th; const float* wr = ws + ((size_t)head * 128 + t) * 128; float acc = 0.f;
        for (int s = 0; s <= t; ++s) acc += wr[s] * vn[s * 128 + d];
        acc += bs[head * 128 + t];
        const size_t m = m0 + t; const float u = bf2f(proj[m * NPROJ + OFF_U + head * 128 + d]), zg = bf2f(proj[m * NPROJ + OFF_ZG + head * 128 + d]);
        yt[t * 129 + d] = u * acc * silu_f(zg); }
    __syncthreads();
    const int t2 = tid >> 2, qd = tid & 3; float ss = 0.f;
    for (int i = 0; i < 32; ++i) { const float y = yt[t2 * 129 + qd * 32 + i]; ss += y * y; }
    ss += __shfl_xor(ss, 1); ss += __shfl_xor(ss, 2);
    const float rstd = rsqrtf(ss * (1.f / 128.f) + EPS);
    bf16* o = proj + (m0 + t2) * NPROJ + OFF_U + head * 128 + qd * 32;
    for (int i = 0; i < 32; ++i) o[i] = (bf16)f2bf(yt[t2 * 129 + qd * 32 + i] * rstd);
    __syncthreads();
}
__device__ __forceinline__ void ph_conv(const bf16* proj, const float* cw, const float* cb, bf16* xc, int vcu, int G, int tid) {
    for (size_t i = (size_t)vcu * NTHR + tid; i < (size_t)M_TOK * 2048; i += (size_t)G * NTHR) {
        const int ch = (int)(i & 2047); const size_t m = i >> 11; const int t = (int)(m & (SEQ - 1));
        float a = cb[ch];
#pragma unroll
        for (int j = 0; j < 4; ++j) { const int tt = t - 3 + j; if (tt >= 0) a += cw[j * 2048 + ch] * bf2f(proj[(m - 3 + j) * NPROJ + OFF_XBC + ch]); }
        xc[i] = (bf16)f2bf(silu_f(a));
    }
}
__device__ __forceinline__ void states_unit(int unit, const bf16* xc, const float* dt, const float* dacs, float* st, unsigned char* lds, int tid) {
    float* Bs = (float*)lds;
    float* xw = Bs + 128 * 128;
    const int h = unit & 15, bc = unit >> 4, g = h >> 2;
    const size_t m0 = (size_t)bc * CH;
    const float cs_end = dacs[(m0 + 127) * 16 + h];
    for (int i = tid; i < 128 * 128; i += NTHR) { const int l = i >> 7, n = i & 127; Bs[i] = bf2f(xc[(m0 + l) * 2048 + XC_B + g * 128 + n]); }
    for (int i = tid; i < 128 * 64; i += NTHR) { const int l = i >> 6, p = i & 63; const size_t m = m0 + l;
        xw[i] = bf2f(xc[m * 2048 + XC_X + h * 64 + p]) * dt[m * 16 + h] * __expf(cs_end - dacs[m * 16 + h]); }
    __syncthreads();
    const int n = tid & 127, ph = tid >> 7;
    float acc[16];
#pragma unroll
    for (int i = 0; i < 16; ++i) acc[i] = 0.f;
    for (int l = 0; l < 128; ++l) { const float b = Bs[l * 128 + n];
#pragma unroll
        for (int i = 0; i < 16; ++i) acc[i] += xw[l * 64 + ph * 16 + i] * b; }
    float* o = st + ((size_t)unit * 64 + ph * 16) * 128 + n;
#pragma unroll
    for (int i = 0; i < 16; ++i) o[(size_t)i * 128] = acc[i];
    __syncthreads();
}
__device__ __forceinline__ void ph_scan(float* st, const float* dacs, int vcu, int G, int tid) {
    for (int i = vcu * NTHR + tid; i < NBATCH * 16 * 8192; i += G * NTHR) {
        const int e = i & 8191, bh = i >> 13, h = bh & 15, b = bh >> 4;
        float run = 0.f;
        for (int c = 0; c < NCH; ++c) { const size_t idx = ((size_t)((b * 16 + c) * 16 + h)) * 8192 + e; const float s = st[idx];
            const float dec = __expf(dacs[((size_t)(b * SEQ + c * CH + 127)) * 16 + h]);
            st[idx] = run; run = run * dec + s; }
    }
}
__device__ __forceinline__ void ssd_out_unit(int unit, bf16* proj, const bf16* xc, const float* dt, const float* dacs, const float* st, const float* dskip, unsigned char* lds, int tid) {
    float* CB = (float*)lds;
    bf16* CsT = (bf16*)(lds + 66048);
    unsigned char* R2 = lds + 66048 + 32768;
    bf16* Bs = (bf16*)R2; float* xh = (float*)R2;
    float* cs = (float*)(R2 + 32768);
    float* dts = cs + 128;
    float* rowss = dts + 128;
    const int g = unit & 3, bc = unit >> 2;
    const size_t m0 = (size_t)bc * CH;
    for (int i = tid; i < 128 * 128; i += NTHR) { const int l = i >> 7, n = i & 127;
        CsT[n * 128 + l] = xc[(m0 + l) * 2048 + XC_C + g * 128 + n]; Bs[i] = xc[(m0 + l) * 2048 + XC_B + g * 128 + n]; }
    if (tid < 128) rowss[tid] = 0.f;
    __syncthreads();
    const int l = tid & 127, q = tid >> 7;
    {
        float acc[32];
#pragma unroll
        for (int i = 0; i < 32; ++i) acc[i] = 0.f;
        for (int n = 0; n < 128; ++n) { const float c = bf2f(CsT[n * 128 + l]);
#pragma unroll
            for (int i = 0; i < 32; ++i) acc[i] += c * bf2f(Bs[(q * 32 + i) * 128 + n]); }
#pragma unroll
        for (int i = 0; i < 32; ++i) CB[l * 129 + q * 32 + i] = acc[i];
    }
    __syncthreads();
    float yv[4][16]; float ss = 0.f;
    const size_t m = m0 + l;
#pragma unroll
    for (int r = 0; r < 4; ++r) {
        const int h = g * 4 + r;
        for (int i = tid; i < 128 * 64; i += NTHR) { const int s = i >> 6, p = i & 63; xh[i] = bf2f(xc[(m0 + s) * 2048 + XC_X + h * 64 + p]); }
        if (tid < 128) { cs[tid] = dacs[(m0 + tid) * 16 + h]; dts[tid] = dt[(m0 + tid) * 16 + h]; }
        __syncthreads();
        float acc[16];
#pragma unroll
        for (int i = 0; i < 16; ++i) acc[i] = 0.f;
        const float csl = cs[l];
        {
            const float* pv = st + ((size_t)(bc * 16 + h) * 64 + q * 16) * 128;
            for (int n = 0; n < 128; ++n) { const float c = bf2f(CsT[n * 128 + l]);
#pragma unroll
                for (int i = 0; i < 16; ++i) acc[i] += c * pv[i * 128 + n]; }
            const float el0 = __expf(csl);
#pragma unroll
            for (int i = 0; i < 16; ++i) acc[i] *= el0;
        }
        for (int s = 0; s < 128; ++s) {
            const float e = __expf(fminf(csl - cs[s], 0.f));
            const float coef = (s <= l) ? CB[l * 129 + s] * e * dts[s] : 0.f;
#pragma unroll
            for (int i = 0; i < 16; ++i) acc[i] += coef * xh[s * 64 + q * 16 + i];
        }
        const float dsk = dskip[h];
#pragma unroll
        for (int i = 0; i < 16; ++i) {
            const float y = acc[i] + dsk * xh[l * 64 + q * 16 + i];
            const float z = bf2f(proj[m * NPROJ + OFF_Z + h * 64 + q * 16 + i]);
            const float gy = y * silu_f(z); yv[r][i] = gy; ss += gy * gy; }
        __syncthreads();
    }
    atomicAdd(&rowss[l], ss);
    __syncthreads();
    const float rstd = rsqrtf(rowss[l] * (1.f / 256.f) + EPS);
#pragma unroll
    for (int r = 0; r < 4; ++r) { bf16* o = proj + m * NPROJ + OFF_V + g * 256 + r * 64 + q * 16;
#pragma unroll
        for (int i = 0; i < 16; ++i) o[i] = (bf16)f2bf(yv[r][i] * rstd); }
    __syncthreads();
}
__device__ __forceinline__ void ph_post(const float* xin, const float* mixed, const float* post_w, float* out, bf16* h, int vcu, int G, int wave, int lane) {
    for (int m = vcu * NWAVES + wave; m < M_TOK; m += G * NWAVES) {
        const f32x4* mr = (const f32x4*)(mixed + (size_t)m * DM) + lane; const f32x4* xr = (const f32x4*)(xin + (size_t)m * DM) + lane; const f32x4* pw = (const f32x4*)post_w + lane;
        f32x4 v[4]; float s = 0.f;
#pragma unroll
        for (int j = 0; j < 4; ++j) { v[j] = mr[64 * j]; s += (v[j].x * v[j].x + v[j].y * v[j].y) + (v[j].z * v[j].z + v[j].w * v[j].w); }
        const float rstd = rsqrtf(wave_sum(s) * (1.f / DM) + EPS); float s2 = 0.f;
#pragma unroll
        for (int j = 0; j < 4; ++j) { v[j] = xr[64 * j] + v[j] * rstd * pw[64 * j]; s2 += (v[j].x * v[j].x + v[j].y * v[j].y) + (v[j].z * v[j].z + v[j].w * v[j].w); }
        f32x4* orow = (f32x4*)(out + (size_t)m * DM) + lane;
#pragma unroll
        for (int j = 0; j < 4; ++j) orow[64 * j] = v[j];
        const float rstd2 = rsqrtf(wave_sum(s2) * (1.f / DM) + EPS);
        unsigned long long* o8 = (unsigned long long*)(h + (size_t)m * DM) + lane;
#pragma unroll
        for (int j = 0; j < 4; ++j) o8[64 * j] = (unsigned long long)pk2(v[j].x * rstd2, v[j].y * rstd2) | ((unsigned long long)pk2(v[j].z * rstd2, v[j].w * rstd2) << 32);
    }
}

struct Args { const float* in[16]; float* out; unsigned char* ws; };
__global__ void __launch_bounds__(NTHR, 2) mk_fwd(Args a) {
    extern __shared__ __attribute__((aligned(16))) unsigned char lds[];
    const int tid0 = threadIdx.x;
    const int G = gridDim.x; const int bx = blockIdx.x; const int vcu = (G % 8 == 0) ? (bx % 8) * (G / 8) + bx / 8 : bx;
    LAS unsigned char* L = (LAS unsigned char*)lds;
    volatile LAS unsigned* MISC = (volatile LAS unsigned*)(L + LDSCTL_OFF);
    for (int u = tid0; u < 128; u += NTHR) ((LAS unsigned*)(L + LDSCTL_OFF))[u] = 0u;
    __syncthreads();
    typedef __attribute__((address_space(4))) const unsigned char* kptr_t;
    const kptr_t kp0 = (kptr_t)__builtin_amdgcn_kernarg_segment_ptr();
#define KP_FRESH kptr_t kp = kp0; asm volatile("" : "+s"(kp)); int tid = tid0; asm volatile("" : "+v"(tid)); const int lane = tid & 63, wave = __builtin_amdgcn_readfirstlane(tid >> 6); (void)lane; (void)wave
#define KIN(i) (*(const float* const __attribute__((address_space(4)))*)(kp + 8 * (i)))
#define KOUT (*(float* const __attribute__((address_space(4)))*)(kp + 8 * 16))
#define KWS (*(unsigned char* const __attribute__((address_space(4)))*)(kp + 8 * 17))
    XcdBarrier bar;
    { KP_FRESH; bar = xcd_barrier_post((unsigned*)(KWS + WS_CTL) + CW_BAR, MISC + 8); }

    { KP_FRESH; unsigned char* ws = KWS;
      ph_prep_w(KIN(2), KIN(1), KIN(14), KIN(7), KIN(13), (bf16*)(ws + WS_WIN), (bf16*)(ws + WS_WOUT), (float*)(ws + WS_WDT), lds, vcu, G, wave, lane, tid);
      ph_h0(KIN(0), (bf16*)(ws + WS_H), vcu, G, wave, lane); }
    xcd_barrier(bar);
    for (int l = 0; l < DEPTH; ++l) {
        {
            KP_FRESH; unsigned char* ws = KWS;
            pg8::Gemm g{(bf16*)(ws + WS_H), (bf16*)(ws + WS_WIN), M_TOK, NPROJ, DM, DM}; pg8::StaticOrder S; S.init(M_TOK, NPROJ, G, bx);
            pg8::EpiBf16<0> E{(bf16*)(ws + WS_PROJ), NPROJ, nullptr, 0, 0, 1.f};
            pg8::gemm_phase<pg8::EpiBf16<0>, pg8::StaticOrder, true, true>(L, g, S, E);
        }
        { KP_FRESH; unsigned char* ws = KWS; ph_dt((bf16*)(ws + WS_H), (float*)(ws + WS_WDT), KIN(10) + l * 16, (float*)(ws + WS_DT), vcu, G, wave, lane); }
        xcd_barrier(bar);
        { KP_FRESH; unsigned char* ws = KWS; bf16* proj = (bf16*)(ws + WS_PROJ);
          for (int u = vcu; u < NBATCH * NCH * 8; u += G) gmlp_unit(u, proj, KIN(3) + l * 1024, KIN(4) + l * 1024, KIN(5) + (size_t)l * 8 * 128 * 128, KIN(6) + l * 8 * 128, lds, tid, wave, lane);
          ph_conv(proj, KIN(8) + (size_t)l * 4 * 2048, KIN(9) + l * 2048, (bf16*)(ws + WS_XC), vcu, G, tid);
          ph_dacs((float*)(ws + WS_DT), KIN(11) + l * 16, (float*)(ws + WS_DACS), vcu, G, tid); }
        xcd_barrier(bar);
        { KP_FRESH; unsigned char* ws = KWS;
          for (int u = vcu; u < NBATCH * NCH * 16; u += G) states_unit(u, (bf16*)(ws + WS_XC), (float*)(ws + WS_DT), (float*)(ws + WS_DACS), (float*)(ws + WS_ST), lds, tid); }
        xcd_barrier(bar);
        { KP_FRESH; unsigned char* ws = KWS; ph_scan((float*)(ws + WS_ST), (float*)(ws + WS_DACS), vcu, G, tid); }
        xcd_barrier(bar);
        { KP_FRESH; unsigned char* ws = KWS;
          for (int u = vcu; u < NBATCH * NCH * 4; u += G) ssd_out_unit(u, (bf16*)(ws + WS_PROJ), (bf16*)(ws + WS_XC), (float*)(ws + WS_DT), (float*)(ws + WS_DACS), (float*)(ws + WS_ST), KIN(12) + l * 16, lds, tid); }
        xcd_barrier(bar);
        {
            KP_FRESH; unsigned char* ws = KWS;
            pg8::Gemm g{(bf16*)(ws + WS_PROJ), (bf16*)(ws + WS_WOUT), M_TOK, DM, 2048, NPROJ}; pg8::StaticOrder S; S.init(M_TOK, DM, G, bx);
            pg8::EpiF32 E{(float*)(ws + WS_MIXED), DM, nullptr};
            pg8::gemm_phase<pg8::EpiF32, pg8::StaticOrder, true, true>(L, g, S, E);
        }
        xcd_barrier(bar);
        { KP_FRESH; unsigned char* ws = KWS; float* out = KOUT;
          ph_post(l == 0 ? KIN(0) : out, (float*)(ws + WS_MIXED), KIN(15) + l * DM, out, (bf16*)(ws + WS_H), vcu, G, wave, lane);
          if (l + 1 < DEPTH)
            ph_prep_w(KIN(2) + (size_t)(l + 1) * DM * INCOLS, KIN(1) + (l + 1) * DM, KIN(14) + (size_t)(l + 1) * 2048 * DM, KIN(7) + (l + 1) * 1024, KIN(13) + (l + 1) * 1024,
                      (bf16*)(ws + WS_WIN), (bf16*)(ws + WS_WOUT), (float*)(ws + WS_WDT), lds, vcu, G, wave, lane, tid); }
        if (l + 1 < DEPTH) xcd_barrier(bar);
    }
}

extern "C" void kernel_launch(void* const* d_in, const int* in_sizes, int n_in, void* d_out, int out_size, void* d_ws, size_t ws_size, hipStream_t stream) {
    static int grid = 0;
    if (grid == 0) {
        if (n_in != 16 || ws_size < WS_END || out_size != M_TOK * DM) { fprintf(stderr, "kernel_launch: unexpected arguments (n_in %d, ws %zu, out %d)\n", n_in, ws_size, out_size); grid = -1; return; }
        int dev = 0, cus = 0, per_cu = 0;
        if (hipGetDevice(&dev) != hipSuccess || hipDeviceGetAttribute(&cus, hipDeviceAttributeMultiprocessorCount, dev) != hipSuccess) { grid = -1; return; }
        if (hipFuncSetAttribute((const void*)mk_fwd, hipFuncAttributeMaxDynamicSharedMemorySize, LDS_BYTES) != hipSuccess) { fprintf(stderr, "kernel_launch: hipFuncSetAttribute failed\n"); grid = -1; return; }
        if (hipOccupancyMaxActiveBlocksPerMultiprocessor(&per_cu, (const void*)mk_fwd, NTHR, LDS_BYTES) != hipSuccess || per_cu < 1) { fprintf(stderr, "kernel_launch: occupancy query says %d blocks per CU\n", per_cu); grid = -1; (void)hipGetLastError(); return; }
        grid = cus;
        if (grid != 256) { fprintf(stderr, "kernel_launch: %d CUs, expected 256\n", grid); }
    }
    if (grid < 0) return;
    (void)hipMemsetAsync((char*)d_ws + WS_CTL, 0, 1 * MiB, stream);
    Args a{};
    for (int i = 0; i < 16; ++i) a.in[i] = (const float*)d_in[i];
    a.out = (float*)d_out; a.ws = (unsigned char*)d_ws;
    hipLaunchKernelGGL(mk_fwd, dim3(grid), dim3(NTHR), LDS_BYTES, stream, a);
}
```

```cpp
#include <hip/hip_runtime.h>
#include <cstdio>
#include <cstdint>
namespace pg8 {
#define PG8_LAS __attribute__((address_space(3)))
typedef unsigned short bf16_t;
typedef short bf16x8 __attribute__((ext_vector_type(8)));
typedef float f32x4 __attribute__((ext_vector_type(4)));
typedef unsigned u32x4 __attribute__((ext_vector_type(4)));
constexpr int BM = 256, BK = 64, HALF = 128, HTB = HALF * BK * 2  , STAGE_BYTES = 8 * HTB, NXCD = 8, WGM = 8;

__host__ __device__ __forceinline__ int lds_byte(int r, int c) { const int st = (r >> 4) * 2 + (c >> 5), rr = r & 15, cc = c & 31, ob = rr * 64 + cc * 2; return st * 1024 + (ob ^ (((ob >> 9) & 1) << 5)); }
__host__ __device__ __forceinline__ void stage_rc(int b, int& R, int& C) { const int st = b / 1024, sb = b % 1024, swz = sb ^ (((sb >> 9) & 1) << 5); R = (st >> 1) * 16 + swz / 64; C = (st & 1) * 32 + (swz % 64) / 2; }
__host__ __device__ __forceinline__ int perm32(int rho) { const int n = rho >> 4, i = rho & 15; return 8 * (i >> 2) + 4 * n + (i & 3); }

struct Unit { int pm, pn; };
struct Gemm { const bf16_t* A; const bf16_t* Bt; int M, N, K, lda; };

struct StaticOrder {
    int nM, nN, nwg, G, c;
    __host__ __device__ void init(int M, int N, int G_, int c_) { nM = M / BM; nN = N / BM; nwg = nM * nN; G = G_; c = c_; }
    __host__ __device__ bool next(int i, Unit& u) const {
        const long L = (long)i * G + c; if (L >= nwg) return false;
        int wgid = (int)L; { const int q = nwg / NXCD, r = nwg % NXCD, xcd = wgid % NXCD, off = wgid / NXCD; wgid = (xcd < r ? xcd * (q + 1) : r * (q + 1) + (xcd - r) * q) + off; }
        const int nig = WGM * nN, gid = wgid / nig, fm = gid * WGM, gsz = (nM - fm) < WGM ? (nM - fm) : WGM;
        u.pm = fm + ((wgid % nig) % gsz); u.pn = (wgid % nig) / gsz; return true;
    }
    __device__ __forceinline__ void a_ready(const Unit&) const {}
    __device__ __forceinline__ void done(const Unit&) const {}
};

__device__ __forceinline__ unsigned cvt_pk_bf16(float lo, float hi) { unsigned r; asm volatile("v_cvt_pk_bf16_f32 %0, %1, %2" : "=v"(r) : "v"(lo), "v"(hi)); return r; }
typedef float f32x2 __attribute__((ext_vector_type(2)));
__device__ __forceinline__ f32x2 gelu_pk(f32x2 v) {
    const f32x2 av = __builtin_elementwise_abs(v), d = av * 0.2316418882f + 1.0f;
    f32x2 t; t.x = __builtin_amdgcn_rcpf(d.x); t.y = __builtin_amdgcn_rcpf(d.y);
    f32x2 q = t * 0.5307027145f + (-0.7265760135f); q = q * t + 0.7107068705f; q = q * t + (-0.142248368f); q = q * t + 0.127414796f; q = q * t;
    const f32x2 s = (v * v) * (-0.72134752044f);
    f32x2 e; e.x = __builtin_amdgcn_exp2f(s.x); e.y = __builtin_amdgcn_exp2f(s.y);
    const f32x2 m = v * (q * e), r = v - m;
    f32x2 o; o.x = v.x < 0.f ? m.x : r.x; o.y = v.y < 0.f ? m.y : r.y; return o;
}

template <int ACT  > struct EpiBf16 {
    static constexpr bool PERM = true, AFTER_DRAIN = false; static_assert(ACT == 0 || ACT == 1, "EpiBf16: ACT is 0 (none) or 1 (gelu_pk)");
    bf16_t* O; int ldc; const float* bias; int split_cols; size_t split_stride; float scale0;
    __device__ __forceinline__ void operator()(const f32x4 (&acc)[2][2][4][2], const Unit& u, int wr, int wc, int fr, int fq) const {
        const int row0 = u.pm * BM + wr * 64 + fr; int colt = u.pn * BM; bf16_t* base = O;
        float sc = 1.f; if (split_cols) { const int t = colt / split_cols; base += (size_t)t * split_stride; colt -= t * split_cols; if (t == 0) sc = scale0; }
        const int col0 = colt + wc * 32 + 8 * fq, bcol0 = u.pn * BM + wc * 32 + 8 * fq;
        f32x4 bv[2][2];
#pragma unroll
        for (int bj = 0; bj < 2; ++bj)
#pragma unroll
            for (int n = 0; n < 2; ++n) bv[bj][n] = bias ? *(const f32x4*)(bias + bcol0 + bj * HALF + 4 * n) : (f32x4){0.f, 0.f, 0.f, 0.f};
#pragma unroll
        for (int ai = 0; ai < 2; ++ai)
#pragma unroll
            for (int m = 0; m < 4; ++m) { bf16_t* rowp = base + (size_t)(row0 + ai * HALF + m * 16) * ldc + col0;
#pragma unroll
                for (int bj = 0; bj < 2; ++bj) { f32x4 v0 = acc[ai][bj][m][0] + bv[bj][0], v1 = acc[ai][bj][m][1] + bv[bj][1];
                    if (ACT == 1) { f32x2 a = gelu_pk((f32x2){v0[0], v0[1]}), b = gelu_pk((f32x2){v0[2], v0[3]}), c = gelu_pk((f32x2){v1[0], v1[1]}), d = gelu_pk((f32x2){v1[2], v1[3]});
                        v0 = (f32x4){a.x, a.y, b.x, b.y}; v1 = (f32x4){c.x, c.y, d.x, d.y}; }
                    v0 = v0 * sc; v1 = v1 * sc; u32x4 w; w.x = cvt_pk_bf16(v0[0], v0[1]); w.y = cvt_pk_bf16(v0[2], v0[3]); w.z = cvt_pk_bf16(v1[0], v1[1]); w.w = cvt_pk_bf16(v1[2], v1[3]);
                    *(u32x4*)(rowp + bj * HALF) = w; } }
    }
};
struct EpiProj {
    static constexpr bool PERM = true, AFTER_DRAIN = false;
    bf16_t* O; int ldc; float* vpart; int M;
    __device__ __forceinline__ void operator()(const f32x4 (&acc)[2][2][4][2], const Unit& u, int wr, int wc, int fr, int fq) const {
        const int row0 = u.pm * BM + wr * 64 + fr; const int col0 = u.pn * BM + wc * 32 + 8 * fq;
        const bool isv = (u.pn >= 4 && u.pn < 8);
#pragma unroll
        for (int ai = 0; ai < 2; ++ai)
#pragma unroll
            for (int m = 0; m < 4; ++m) { const int row = row0 + ai * HALF + m * 16; bf16_t* rowp = O + (size_t)row * ldc + col0;
                float s = 0.f, q = 0.f;
#pragma unroll
                for (int bj = 0; bj < 2; ++bj) { const f32x4 v0 = acc[ai][bj][m][0], v1 = acc[ai][bj][m][1];
                    s += (v0[0] + v0[1]) + (v0[2] + v0[3]) + (v1[0] + v1[1]) + (v1[2] + v1[3]);
                    q += (v0[0] * v0[0] + v0[1] * v0[1]) + (v0[2] * v0[2] + v0[3] * v0[3]) + (v1[0] * v1[0] + v1[1] * v1[1]) + (v1[2] * v1[2] + v1[3] * v1[3]);
                    u32x4 w; w.x = cvt_pk_bf16(v0[0], v0[1]); w.y = cvt_pk_bf16(v0[2], v0[3]); w.z = cvt_pk_bf16(v1[0], v1[1]); w.w = cvt_pk_bf16(v1[2], v1[3]);
                    *(u32x4*)(rowp + bj * HALF) = w; }
                if (isv) { s += __shfl_xor(s, 16); s += __shfl_xor(s, 32); q += __shfl_xor(q, 16); q += __shfl_xor(q, 32);
                    if (fq == 0) { f32x2 sq; sq.x = s; sq.y = q; *(f32x2*)(vpart + ((size_t)((u.pn - 4) * 4 + wc) * M + row) * 2) = sq; } }
            }
    }
};
struct EpiF32 {
    static constexpr bool PERM = false, AFTER_DRAIN = false;
    float* C; int ldc; const float* bias;
    __device__ __forceinline__ void operator()(const f32x4 (&acc)[2][2][4][2], const Unit& u, int wr, int wc, int fr, int fq) const {
        const int row0 = u.pm * BM + wr * 64 + fr, col0 = u.pn * BM + wc * 32 + 4 * fq;
        f32x4 bv[2][2];
#pragma unroll
        for (int bj = 0; bj < 2; ++bj)
#pragma unroll
            for (int n = 0; n < 2; ++n) bv[bj][n] = bias ? *(const f32x4*)(bias + col0 + bj * HALF + n * 16) : (f32x4){0.f, 0.f, 0.f, 0.f};
#pragma unroll
        for (int ai = 0; ai < 2; ++ai)
#pragma unroll
            for (int m = 0; m < 4; ++m) { float* rowp = C + (size_t)(row0 + ai * HALF + m * 16) * ldc + col0;
#pragma unroll
                for (int bj = 0; bj < 2; ++bj)
#pragma unroll
                    for (int n = 0; n < 2; ++n) *(f32x4*)(rowp + bj * HALF + n * 16) = acc[ai][bj][m][n] + bv[bj][n]; }
    }
};
template <class Epi, class Sched, bool ALIGN_EPI = false, bool SP2 = false>
__device__ __forceinline__ void gemm_phase(PG8_LAS unsigned char* lds, const Gemm g, const Sched& S, const Epi& E) {
    int tid_ = threadIdx.x; asm volatile("" : "+v"(tid_));
    const int tid = tid_, wid = __builtin_amdgcn_readfirstlane(tid >> 6), lane = tid & 63, wr = wid >> 2, wc = wid & 3, fr = lane & 15, fq = lane >> 4;
    const int K = g.K, nt = K / BK;
    unsigned voffA[2], voffB[2];
#pragma unroll
    for (int i = 0; i < 2; ++i) { int R, C; stage_rc(tid * 16 + i * 8192, R, C); const int Rb = Epi::PERM ? ((R & ~31) + perm32(R & 31)) : R;
        voffA[i] = (unsigned)(R * g.lda + C) * 2u; voffB[i] = (unsigned)(Rb * K + C) * 2u; }
    const size_t kstep = (size_t)(BK * 2);
    const size_t hstepA = (size_t)HALF * g.lda * 2, hstepB = (size_t)HALF * K * 2;
    const size_t tstepA = 2 * hstepA, tstepB = 2 * hstepB;
    const unsigned ldsw = (unsigned)wid * 1024u;
    const int aoff = lds_byte(wr * 64 + fr, fq * 8), boff = lds_byte(wc * 32 + fr, fq * 8);
#define PG8_SA(b, h) (((b) * 2 + (h)) * HTB)
#define PG8_SB(b, h) ((4 + (b) * 2 + (h)) * HTB)
#define PG8_STAGE(bufoff, gbase, voff) do { _Pragma("unroll") for (int _i = 0; _i < 2; ++_i) \
        __builtin_amdgcn_global_load_lds((const unsigned*)((const char*)(gbase) + (voff)[_i]), (PG8_LAS unsigned*)(lds + (bufoff) + ldsw + _i * 8192), 16, 0, 0); } while (0)
#define PG8_LDA(dst, b, h) do { _Pragma("unroll") for (int m = 0; m < 4; ++m) _Pragma("unroll") for (int k = 0; k < 2; ++k) dst[m][k] = *(const PG8_LAS bf16x8*)(lds + PG8_SA(b, h) + aoff + m * 2048 + k * 1024); } while (0)
#define PG8_LDB(dst, b, h) do { _Pragma("unroll") for (int n = 0; n < 2; ++n) _Pragma("unroll") for (int k = 0; k < 2; ++k) dst[n][k] = *(const PG8_LAS bf16x8*)(lds + PG8_SB(b, h) + boff + n * 2048 + k * 1024); } while (0)
#define PG8_MMA(ai, bj, At, Bt) do { __builtin_amdgcn_s_setprio(1); _Pragma("unroll") for (int m = 0; m < 4; ++m) _Pragma("unroll") for (int n = 0; n < 2; ++n) _Pragma("unroll") for (int k = 0; k < 2; ++k) \
        acc[ai][bj][m][n] = __builtin_amdgcn_mfma_f32_16x16x32_bf16(Bt[n][k], At[m][k], acc[ai][bj][m][n], 0, 0, 0); __builtin_amdgcn_s_setprio(0); } while (0)
#define PG8_WAIT_V(n) asm volatile("s_waitcnt vmcnt(" #n ")" ::: "memory")
#define PG8_WAIT_L(n) asm volatile("s_waitcnt lgkmcnt(" #n ")" ::: "memory")
#define PG8_BAR __builtin_amdgcn_s_barrier()
#define PG8_SCHED __builtin_amdgcn_sched_barrier(0)
    Unit cur, nxt; int ui = 0;
    if (!S.next(0, cur)) return;
    f32x4 acc[2][2][4][2];
#pragma unroll
    for (int a = 0; a < 2; ++a)
#pragma unroll
        for (int b = 0; b < 2; ++b)
#pragma unroll
            for (int m = 0; m < 4; ++m)
#pragma unroll
                for (int n = 0; n < 2; ++n) acc[a][b][m][n] = (f32x4){0.f, 0.f, 0.f, 0.f};
    bf16x8 At[4][2], B0[2][2], B1[2][2];
    const char* cA = (const char*)g.A + (size_t)cur.pm * tstepA; const char* cB = (const char*)g.Bt + (size_t)cur.pn * tstepB;
    S.a_ready(cur);
    if constexpr (SP2) {
        PG8_STAGE(PG8_SB(0, 0), cB, voffB); PG8_STAGE(PG8_SB(0, 1), cB + hstepB, voffB); PG8_STAGE(PG8_SA(0, 0), cA, voffA); PG8_STAGE(PG8_SA(0, 1), cA + hstepA, voffA);
        if (wr == 1) PG8_BAR;
        PG8_WAIT_V(2); PG8_BAR;
        PG8_STAGE(PG8_SB(1, 0), cB + kstep, voffB); PG8_STAGE(PG8_SA(1, 0), cA + kstep, voffA); PG8_STAGE(PG8_SB(1, 1), cB + hstepB + kstep, voffB);
        PG8_WAIT_V(6); PG8_BAR;
    } else {
        PG8_STAGE(PG8_SB(0, 0), cB, voffB); PG8_STAGE(PG8_SA(0, 0), cA, voffA); PG8_STAGE(PG8_SB(0, 1), cB + hstepB, voffB); PG8_STAGE(PG8_SA(0, 1), cA + hstepA, voffA);
        if (wr == 1) PG8_BAR;
        PG8_WAIT_V(4); PG8_BAR;
        PG8_STAGE(PG8_SB(1, 0), cB + kstep, voffB); PG8_STAGE(PG8_SA(1, 0), cA + kstep, voffA); PG8_STAGE(PG8_SB(1, 1), cB + hstepB + kstep, voffB);
        PG8_WAIT_V(6); PG8_BAR;
    }
    for (;;) {
        const bool has_next = S.next(ui + 1, nxt);
        const char* nA = has_next ? (const char*)g.A + (size_t)nxt.pm * tstepA : cA; const char* nB = has_next ? (const char*)g.Bt + (size_t)nxt.pn * tstepB : cB;
        for (int t = 0; t < nt; t += 2) {
            const bool last = (t == nt - 2);
            const char* a1 = cA + (size_t)(t + 1) * kstep;
            const char* a2 = last ? nA : cA + (size_t)(t + 2) * kstep; const char* b2 = last ? nB : cB + (size_t)(t + 2) * kstep;
            const char* a3 = a2 + kstep; const char* b3 = b2 + kstep;
            if (last && has_next) S.a_ready(nxt);
            if constexpr (SP2) {
            PG8_LDB(B0, 0, 0); PG8_LDB(B1, 0, 1); PG8_SCHED; PG8_LDA(At, 0, 0); PG8_STAGE(PG8_SA(1, 1), a1 + hstepA, voffA);
            PG8_WAIT_V(8); PG8_WAIT_L(0); PG8_BAR; PG8_MMA(0, 0, At, B0); PG8_MMA(0, 1, At, B1); PG8_BAR; PG8_SCHED;
            PG8_LDA(At, 0, 1); PG8_STAGE(PG8_SB(0, 0), b2, voffB); PG8_STAGE(PG8_SB(0, 1), b2 + hstepB, voffB); PG8_STAGE(PG8_SA(0, 0), a2, voffA);
            PG8_WAIT_V(8); PG8_WAIT_L(0); PG8_BAR; PG8_MMA(1, 0, At, B0); PG8_MMA(1, 1, At, B1); PG8_BAR; PG8_SCHED;
            PG8_LDB(B0, 1, 0); PG8_LDB(B1, 1, 1); PG8_SCHED; PG8_LDA(At, 1, 0); PG8_STAGE(PG8_SA(0, 1), a2 + hstepA, voffA);
            PG8_WAIT_V(8); PG8_WAIT_L(0); PG8_BAR; PG8_MMA(0, 0, At, B0); PG8_MMA(0, 1, At, B1); PG8_BAR; PG8_SCHED;
            PG8_LDA(At, 1, 1); PG8_STAGE(PG8_SB(1, 0), b3, voffB); PG8_STAGE(PG8_SB(1, 1), b3 + hstepB, voffB); PG8_STAGE(PG8_SA(1, 0), a3, voffA);
            PG8_WAIT_V(8); PG8_WAIT_L(0); PG8_BAR; PG8_MMA(1, 0, At, B0); PG8_MMA(1, 1, At, B1); PG8_BAR; PG8_SCHED;
            } else {
            PG8_LDB(B0, 0, 0); PG8_SCHED; PG8_LDA(At, 0, 0); PG8_STAGE(PG8_SA(1, 1), a1 + hstepA, voffA);
            PG8_WAIT_L(8); PG8_BAR; PG8_WAIT_L(0); PG8_MMA(0, 0, At, B0); PG8_BAR; PG8_SCHED;
            PG8_LDB(B1, 0, 1); PG8_STAGE(PG8_SB(0, 0), b2, voffB);
            PG8_BAR; PG8_WAIT_L(0); PG8_MMA(0, 1, At, B1); PG8_BAR;
            PG8_LDA(At, 0, 1); PG8_STAGE(PG8_SA(0, 0), a2, voffA);
            PG8_BAR; PG8_WAIT_L(0); PG8_MMA(1, 0, At, B0); PG8_BAR; PG8_SCHED;
            PG8_STAGE(PG8_SB(0, 1), b2 + hstepB, voffB);
            PG8_WAIT_V(6); PG8_BAR; PG8_MMA(1, 1, At, B1); PG8_BAR;
            PG8_LDB(B0, 1, 0); PG8_SCHED; PG8_LDA(At, 1, 0); PG8_STAGE(PG8_SA(0, 1), a2 + hstepA, voffA);
            PG8_WAIT_L(8); PG8_BAR; PG8_WAIT_L(0); PG8_MMA(0, 0, At, B0); PG8_BAR; PG8_SCHED;
            PG8_LDB(B1, 1, 1); PG8_STAGE(PG8_SB(1, 0), b3, voffB);
            PG8_BAR; PG8_WAIT_L(0); PG8_MMA(0, 1, At, B1); PG8_BAR;
            PG8_LDA(At, 1, 1); PG8_STAGE(PG8_SA(1, 0), a3, voffA);
            PG8_BAR; PG8_WAIT_L(0); PG8_MMA(1, 0, At, B0); PG8_BAR; PG8_SCHED;
            PG8_STAGE(PG8_SB(1, 1), b3 + hstepB, voffB);
            PG8_WAIT_V(6); PG8_BAR; PG8_MMA(1, 1, At, B1); PG8_BAR;
            }
        }
        if constexpr (ALIGN_EPI) { if (wr == 0) PG8_BAR; }
        if constexpr (!Epi::AFTER_DRAIN) { E(acc, cur, wr, wc, fr, fq); S.done(cur); }
        if (!has_next) break;
#pragma unroll
        for (int a = 0; a < 2; ++a)
#pragma unroll
            for (int b = 0; b < 2; ++b)
#pragma unroll
                for (int m = 0; m < 4; ++m)
#pragma unroll
                    for (int n = 0; n < 2; ++n) acc[a][b][m][n] = (f32x4){0.f, 0.f, 0.f, 0.f};
        cur = nxt; cA = nA; cB = nB; ++ui;
        if constexpr (ALIGN_EPI) { if (wr == 1) PG8_BAR; }
    }
    PG8_WAIT_V(0);
    if constexpr (!ALIGN_EPI) { if (wr == 0) PG8_BAR; }
    PG8_BAR;
    if constexpr (Epi::AFTER_DRAIN) { E.fused(acc, cur, wr, wc, fr, fq, lds, wid, lane); S.done(cur); }
#undef PG8_SA
#undef PG8_SB
#undef PG8_STAGE
#undef PG8_LDA
#undef PG8_LDB
#undef PG8_MMA
#undef PG8_WAIT_V
#undef PG8_WAIT_L
#undef PG8_BAR
#undef PG8_SCHED
}
}

constexpr int M_TOK = 16384, DM = 1024, SEQ = 2048, NBATCH = 8, NCH = 16, CH = 128, DEPTH = 4;
constexpr int NPROJ = 6144, INCOLS = 6160;
constexpr int OFF_U = 0, OFF_V = 1024, OFF_ZG = 2048, OFF_Z = 3072, OFF_XBC = 4096;
constexpr int XC_X = 0, XC_B = 1024, XC_C = 1536;
constexpr float EPS = 1e-6f;
typedef unsigned short bf16;
typedef float f32x4 __attribute__((ext_vector_type(4)));
typedef unsigned v4u __attribute__((ext_vector_type(4)));

__device__ __forceinline__ unsigned f2bf(float f) { unsigned u = __builtin_bit_cast(unsigned, f); return (u + 0x7fffu + ((u >> 16) & 1u)) >> 16; }
__device__ __forceinline__ unsigned pk2(float lo, float hi) { return f2bf(lo) | (f2bf(hi) << 16); }
__device__ __forceinline__ float bf2f(unsigned short h) { return __builtin_bit_cast(float, (unsigned)h << 16); }
__device__ __forceinline__ float silu_f(float x) { return x / (1.0f + __expf(-x)); }
__device__ __forceinline__ float softplus_f(float x) { return fmaxf(x, 0.f) + log1pf(__expf(-fabsf(x))); }
__device__ __forceinline__ float wave_sum(float v) {
#pragma unroll
    for (int o = 1; o < 64; o <<= 1) v += __shfl_xor(v, o);
    return v;
}

constexpr size_t MiB = 1u << 20;
constexpr size_t WS_CTL = 0;
constexpr size_t WS_WIN = 1 * MiB;
constexpr size_t WS_WOUT = 13 * MiB;
constexpr size_t WS_WDT = 17 * MiB;
constexpr size_t WS_C2 = 17 * MiB + 256 * 1024;
constexpr size_t WS_CDEC = 17 * MiB + 512 * 1024;
constexpr size_t WS_DT = 18 * MiB;
constexpr size_t WS_DACS = 19 * MiB;
constexpr size_t WS_WCI = 20 * MiB;
constexpr size_t WS_VPART = 21 * MiB;
constexpr size_t WS_PROJ = 23 * MiB;
constexpr size_t WS_XC = 215 * MiB;
constexpr size_t WS_H = WS_XC;
constexpr size_t WS_ST = 279 * MiB;
constexpr size_t WS_MIXED = WS_ST;
constexpr size_t WS_END = 343 * MiB;


#define LAS __attribute__((address_space(3)))

__device__ __forceinline__ void transpose_item(const float* W, int K, int ldw, int nblk, const float* scale, bf16* WT, float* scr, int item, int lane) {
    const int kb = item / nblk, nb = item % nblk, k0 = 64 * kb, n0 = 32 * nb;
#pragma unroll 8
    for (int i = 0; i < 32; ++i) { const int kk = 2 * i + (lane >> 5); scr[kk * 33 + (lane & 31)] = W[(size_t)(k0 + kk) * ldw + n0 + (lane & 31)] * scale[k0 + kk]; }
    __builtin_amdgcn_wave_barrier(); asm volatile("s_waitcnt lgkmcnt(0)" ::: "memory");
    const int c = lane & 7;
#pragma unroll
    for (int j = 0; j < 4; ++j) { const int n = (lane >> 3) + 8 * j; const float* s = scr + (8 * c) * 33 + n;
        v4u o; o.x = pk2(s[0 * 33], s[1 * 33]); o.y = pk2(s[2 * 33], s[3 * 33]); o.z = pk2(s[4 * 33], s[5 * 33]); o.w = pk2(s[6 * 33], s[7 * 33]);
        *(v4u*)(WT + (size_t)(n0 + n) * K + k0 + 8 * c) = o; }
    __builtin_amdgcn_wave_barrier(); asm volatile("s_waitcnt lgkmcnt(0)" ::: "memory");
}

__device__ __forceinline__ void rms_row_to_bf16(const float* xrow, bf16* orow, int lane) {
    const f32x4* xr = (const f32x4*)xrow + lane;
    f32x4 v[4]; float s = 0.f;
#pragma unroll
    for (int j = 0; j < 4; ++j) { v[j] = xr[64 * j]; s += (v[j].x * v[j].x + v[j].y * v[j].y) + (v[j].z * v[j].z + v[j].w * v[j].w); }
    const float rstd = rsqrtf(wave_sum(s) * (1.f / DM) + EPS);
    unsigned long long* o8 = (unsigned long long*)orow + lane;
#pragma unroll
    for (int j = 0; j < 4; ++j) o8[64 * j] = (unsigned long long)pk2(v[j].x * rstd, v[j].y * rstd) | ((unsigned long long)pk2(v[j].z * rstd, v[j].w * rstd) << 32);
}

typedef short bf16x8_t __attribute__((ext_vector_type(8)));
typedef short s16x4 __attribute__((ext_vector_type(4)));
typedef float f32x16 __attribute__((ext_vector_type(16)));
typedef float f32x2_t __attribute__((ext_vector_type(2)));
typedef __bf16 bf16v2 __attribute__((ext_vector_type(2)));
#define MFMA32(a, b, c) __builtin_amdgcn_mfma_f32_32x32x16_bf16((a), (b), (c), 0, 0, 0)
__device__ __forceinline__ unsigned off_b(unsigned row, unsigned ch) { return 256u * row + 16u * (ch ^ (((row & 3u) << 2) | ((row >> 2) & 3u))); }
__device__ __forceinline__ bf16x8_t frag_row(const LAS unsigned char* img, int rb, int s16, int lane) {
    return *(const LAS bf16x8_t*)(img + off_b(32 * rb + (lane & 31), 2 * s16 + (lane >> 5)));
}
__device__ __forceinline__ bf16x8_t frag_tr(const LAS unsigned char* img, int ks, int cb, int lane) {
    const unsigned h = lane >> 5, blk = (lane >> 4) & 1, q = (lane & 15) >> 2, p = lane & 3;
    const s16x4 lo = __builtin_amdgcn_ds_read_tr16_b64_v4i16((LAS s16x4*)(img + off_b(16 * ks + 8 * h + q, 4 * cb + 2 * blk + (p >> 1)) + 8 * (p & 1)));
    const s16x4 hi = __builtin_amdgcn_ds_read_tr16_b64_v4i16((LAS s16x4*)(img + off_b(16 * ks + 8 * h + 4 + q, 4 * cb + 2 * blk + (p >> 1)) + 8 * (p & 1)));
    return __builtin_shufflevector(lo, hi, 0, 1, 2, 3, 4, 5, 6, 7);
}
__device__ __forceinline__ bf16x8_t frag_tr_perm(const LAS unsigned char* img, int ks, int cb, int lane) {
    const unsigned h = lane >> 5, blk = (lane >> 4) & 1, q = (lane & 15) >> 2, p = lane & 3;
    const s16x4 lo = __builtin_amdgcn_ds_read_tr16_b64_v4i16((LAS s16x4*)(img + off_b(16 * ks + 4 * h + q, 4 * cb + 2 * blk + (p >> 1)) + 8 * (p & 1)));
    const s16x4 hi = __builtin_amdgcn_ds_read_tr16_b64_v4i16((LAS s16x4*)(img + off_b(16 * ks + 8 + 4 * h + q, 4 * cb + 2 * blk + (p >> 1)) + 8 * (p & 1)));
    return __builtin_shufflevector(lo, hi, 0, 1, 2, 3, 4, 5, 6, 7);
}
__device__ __forceinline__ unsigned pkbf(float lo, float hi) { f32x2_t v; v.x = lo; v.y = hi; return __builtin_bit_cast(unsigned, __builtin_convertvector(v, bf16v2)); }
__device__ __forceinline__ float bflo(unsigned w) { return __builtin_bit_cast(float, w << 16); }
__device__ __forceinline__ float bfhi(unsigned w) { return __builtin_bit_cast(float, w & 0xffff0000u); }
#define XB_TMO      128
#define XB_XCNT(j)  (256  + 64 * (j))
#define XB_XSUB(j)  (1280 + 64 * (j))
#define XB_XGEN(j)  (2304 + 64 * (j))
#define XB_TOP      3328
#define XB_TOPGEN   3392
#define XCD_BAR_WORDS 3456
#define XB_SPIN_CAP (1u << 22)

__device__ __forceinline__ unsigned xb_ld(unsigned* p)              { return __hip_atomic_load(p, __ATOMIC_RELAXED, __HIP_MEMORY_SCOPE_AGENT); }
__device__ __forceinline__ unsigned xb_add(unsigned* p, unsigned v) { return __hip_atomic_fetch_add(p, v, __ATOMIC_RELAXED, __HIP_MEMORY_SCOPE_AGENT); }
__device__ __forceinline__ unsigned xb_xcc_id() { return (unsigned)__builtin_amdgcn_s_getreg((3 << 11) | 20) & 0xFu; }
#define XB_SPIN(cond, bar) do { unsigned _sp = 0; while (cond) { __builtin_amdgcn_s_sleep(1); \
    if ((++_sp & 255u) == 0u) { if (xb_ld(&(bar)[XB_TMO])) break; if (_sp > XB_SPIN_CAP) { atomicAdd(&(bar)[XB_TMO], 1u); break; } } } } while (0)

struct XcdBarrier {
    unsigned* bar; unsigned x;
    volatile LAS unsigned* st;
};

__device__ __forceinline__ XcdBarrier xcd_barrier_post(unsigned* bar, volatile LAS unsigned* st) {
    XcdBarrier b; b.bar = bar; b.x = xb_xcc_id(); b.st = st;
    if (threadIdx.x == 0) (void)xb_add(&bar[XB_XCNT(b.x)], 1u);
    return b;
}
__device__ __forceinline__ void xcd_barrier_complete(unsigned* bar, unsigned x, unsigned& nloc, unsigned& nx) {
    const unsigned G = gridDim.x * gridDim.y * gridDim.z;
    unsigned sum, cnt, mine, sp = 0u;
    for (;;) {
        sum = 0u; cnt = 0u; mine = 0u;
#pragma unroll
        for (unsigned j = 0; j < 16; ++j) { const unsigned c = xb_ld(&bar[XB_XCNT(j)]); sum += c; cnt += (c > 0u) ? 1u : 0u; mine = (j == x) ? c : mine; }
        if (sum == G) break;
        __builtin_amdgcn_s_sleep(1);
        if ((++sp & 255u) == 0u) { if (xb_ld(&bar[XB_TMO])) break; if (sp > XB_SPIN_CAP) { atomicAdd(&bar[XB_TMO], 1u); break; } }
    }
    nloc = mine > 0u ? mine : 1u; nx = cnt > 0u ? cnt : 1u;
}

__device__ __forceinline__ void xcd_barrier(const XcdBarrier& b) {
    asm volatile("s_waitcnt vmcnt(0)" ::: "memory");
    __syncthreads();
    if (threadIdx.x == 0) {
        unsigned* bar = b.bar;
        __builtin_amdgcn_s_waitcnt(0);
        unsigned nloc = b.st[0], nx = b.st[1];
        if (nloc == 0u) { xcd_barrier_complete(bar, b.x, nloc, nx); b.st[0] = nloc; b.st[1] = nx; }
        const unsigned old = xb_add(&bar[XB_XSUB(b.x)], 1u);
        const unsigned gen = old / nloc;
        if (old + 1u == (gen + 1u) * nloc) {
            __builtin_amdgcn_fence(__ATOMIC_RELEASE, "agent");
            asm volatile("s_waitcnt vmcnt(0)" ::: "memory");
            const unsigned og = xb_add(&bar[XB_TOP], 1u);
            const unsigned tg = og / nx;
            if (og + 1u == (tg + 1u) * nx) xb_add(&bar[XB_TOPGEN], 1u);
            else XB_SPIN(xb_ld(&bar[XB_TOPGEN]) == tg, bar);
            __builtin_amdgcn_fence(__ATOMIC_ACQUIRE, "agent");
            xb_add(&bar[XB_XGEN(b.x)], 1u);
            asm volatile("s_waitcnt vmcnt(0)" ::: "memory");
        } else {
            XB_SPIN(xb_ld(&bar[XB_XGEN(b.x)]) == gen, bar);
            __builtin_amdgcn_fence(__ATOMIC_ACQUIRE, "agent");
            asm volatile("s_waitcnt vmcnt(0)" ::: "memory");
        }
    }
    __syncthreads();
}

constexpr int NTHR = 512, NWAVES = 8;
constexpr int LDS_BYTES = 147456;
constexpr int LDSCTL_OFF = LDS_BYTES - 512;
constexpr int CW_BAR = 4096;

#define OPAQUE_V(x) asm volatile("" : "+v"(x))

__device__ __forceinline__ void ph_prep_w(const float* w_in, const float* pre_w, const float* w_out, const float* gnw, const float* snw, bf16* win_t, bf16* wout_t, float* wdt,
                                          unsigned char* lds, int vcu, int G, int wave, int lane, int tid) {
    float* scr = (float*)(lds + wave * 8448);
    const int gw = vcu * NWAVES + wave, NGW = G * NWAVES;
    constexpr int I_IN = (DM / 64) * (NPROJ / 32);
    constexpr int I_OUT_A = (1024 / 64) * (DM / 32);
    for (int it = gw; it < I_IN + 2 * I_OUT_A; it += NGW) {
        if (it < I_IN) transpose_item(w_in, DM, INCOLS, NPROJ / 32, pre_w, win_t, scr, it, lane);
        else if (it < I_IN + I_OUT_A) transpose_item(w_out, 2048, DM, DM / 32, gnw, wout_t, scr, it - I_IN, lane);
        else transpose_item(w_out + (size_t)1024 * DM, 2048, DM, DM / 32, snw, wout_t + 1024, scr, it - I_IN - I_OUT_A, lane);
    }
    for (int i = vcu * NTHR + tid; i < 16 * DM; i += G * NTHR) { const int j = i / DM, k = i % DM; wdt[i] = w_in[(size_t)k * INCOLS + NPROJ + j] * pre_w[k]; }
}
__device__ __forceinline__ void ph_h0(const float* x, bf16* h, int vcu, int G, int wave, int lane) {
    for (int m = vcu * NWAVES + wave; m < M_TOK; m += G * NWAVES) rms_row_to_bf16(x + (size_t)m * DM, h + (size_t)m * DM, lane);
}
__device__ __forceinline__ void ph_dt(const bf16* h, const float* wdt, const float* dt_bias, float* dt, int vcu, int G, int wave, int lane) {
    for (int m = vcu * NWAVES + wave; m < M_TOK; m += G * NWAVES) {
        float hv[16];
        const bf16* hr = h + (size_t)m * DM + lane * 16;
#pragma unroll
        for (int i = 0; i < 16; ++i) hv[i] = bf2f(hr[i]);
        float mine = 0.f;
        for (int j = 0; j < 16; ++j) {
            const float* wr = wdt + (size_t)j * DM + lane * 16; float a = 0.f;
#pragma unroll
            for (int i = 0; i < 16; ++i) a += hv[i] * wr[i];
            a = wave_sum(a);
            if (lane == j) mine = a;
        }
        if (lane < 16) dt[(size_t)m * 16 + lane] = softplus_f(mine + dt_bias[lane]);
    }
}
__device__ __forceinline__ void ph_dacs(const float* dt, const float* a_log, float* dacs, int vcu, int G, int tid) {
    for (int bc = vcu; bc < NBATCH * NCH; bc += G) {
        if (tid < 16) { const int h = tid; const float a = -__expf(a_log[h]); float cs = 0.f;
            for (int l = 0; l < CH; ++l) { const size_t m = (size_t)bc * CH + l; cs += dt[m * 16 + h] * a; dacs[m * 16 + h] = cs; } }
    }
}
__device__ __forceinline__ void ph_prep_gmlp(const float* gws, unsigned char* wci, float* c2, int vcu, int G, int wave, int lane) {
    for (int row = vcu * NWAVES + wave; row < DEPTH * 8 * 128; row += G * NWAVES) {
        const int t = row & 127; const float* wr = gws + (size_t)row * 128; const int s = 2 * lane;
        const float w0 = (s <= t) ? wr[s] : 0.f, w1 = (s + 1 <= t) ? wr[s + 1] : 0.f;
        *(unsigned*)(wci + (size_t)(row >> 7) * 32768 + off_b(t, s >> 3) + 2 * (s & 7)) = pkbf(w0, w1);
        const float sum = wave_sum(w0 + w1);
        if (lane == 0) c2[row] = sum;
    }
}
__device__ __forceinline__ void gmlp_unit_mfma(int unit, bool load_a, bf16* proj, const float* vpart, const float* vnw, const float* vnb, const unsigned char* wci_l, const float* c2_l, const float* bs_l,
                                               LAS unsigned char* L, int tid, int wave, int lane) {
    LAS unsigned char* A_IMG = L; LAS unsigned char* V_IMG = L + 32768; LAS unsigned char* U_T = L + 65536; LAS unsigned char* Z_T = L + 98304;
    OPAQUE_V(tid); OPAQUE_V(lane);
    LAS float* yss = (LAS float*)(L + 131072);
    const int head = unit & 7, bc = unit >> 3;
    const size_t m0 = (size_t)bc * CH;
#pragma unroll
    for (int k = 0; k < 4; ++k) {
        const int c = tid + NTHR * k, row = c >> 4, ch = c & 15;
        const bf16* prow = proj + (m0 + row) * NPROJ + head * 128 + 8 * ch;
        const v4u uu = *(const v4u*)(prow + OFF_U), zz = *(const v4u*)(prow + OFF_ZG); v4u vv = *(const v4u*)(prow + OFF_V);
        const f32x2_t pq = *(const f32x2_t*)(vpart + ((size_t)ch * M_TOK + m0 + row) * 2);
        float S = pq.x, Q = pq.y;
#pragma unroll
        for (int o = 1; o < 16; o <<= 1) { S += __shfl_xor(S, o); Q += __shfl_xor(Q, o); }
        const float mean = S * (1.f / 1024.f), rstd = rsqrtf(fmaxf(Q * (1.f / 1024.f) - mean * mean, 0.f) + EPS);
        v4u vn;
        vn.x = pkbf((bflo(vv.x) - mean) * rstd, (bfhi(vv.x) - mean) * rstd); vn.y = pkbf((bflo(vv.y) - mean) * rstd, (bfhi(vv.y) - mean) * rstd);
        vn.z = pkbf((bflo(vv.z) - mean) * rstd, (bfhi(vv.z) - mean) * rstd); vn.w = pkbf((bflo(vv.w) - mean) * rstd, (bfhi(vv.w) - mean) * rstd);
        const unsigned o = off_b(row, ch);
        *(LAS v4u*)(V_IMG + o) = vn; *(LAS v4u*)(U_T + o) = uu; *(LAS v4u*)(Z_T + o) = zz;
        if (load_a) *(LAS v4u*)(A_IMG + 16 * c) = *(const v4u*)(wci_l + (size_t)head * 32768 + 16 * c);
    }
    __syncthreads();
    const int db = wave & 3, tset = wave >> 2;
    const int tbA = tset ? 1 : 0, tbB = tset ? 2 : 3;
    f32x16 accA, accB;
#pragma unroll
    for (int i = 0; i < 16; ++i) { accA[i] = 0.f; accB[i] = 0.f; }
#pragma unroll
    for (int ks = 0; ks < 8; ++ks) {
        if (ks < 2 * (tbB + 1)) {
            const bf16x8_t vf = frag_tr(V_IMG, ks, db, lane);
            accB = MFMA32(vf, frag_row(A_IMG, tbB, ks, lane), accB);
            if (ks < 2 * (tbA + 1)) accA = MFMA32(vf, frag_row(A_IMG, tbA, ks, lane), accA);
        }
    }
    const int h = lane >> 5;
#pragma unroll
    for (int which = 0; which < 2; ++which) {
        const int tb = which ? tbB : tbA; const f32x16& acc = which ? accB : accA;
        const int t = 32 * tb + (lane & 31);
        const float c2t = c2_l[head * 128 + t], bst = bs_l[head * 128 + t];
        float ss = 0.f;
#pragma unroll
        for (int g = 0; g < 4; ++g) {
            const int d0 = 32 * db + 8 * g + 4 * h;
            const unsigned o = off_b(t, 4 * db + g) + 8 * h;
            const unsigned long long u8 = *(const LAS unsigned long long*)(U_T + o), z8 = *(const LAS unsigned long long*)(Z_T + o);
            const f32x4 w4 = *(const f32x4*)(vnw + head * 128 + d0), b4 = *(const f32x4*)(vnb + head * 128 + d0);
            const unsigned ulo = (unsigned)u8, uhi = (unsigned)(u8 >> 32), zlo = (unsigned)z8, zhi = (unsigned)(z8 >> 32);
            const float y0 = bflo(ulo) * (w4[0] * acc[4 * g + 0] + b4[0] * c2t + bst) * silu_f(bflo(zlo));
            const float y1 = bfhi(ulo) * (w4[1] * acc[4 * g + 1] + b4[1] * c2t + bst) * silu_f(bfhi(zlo));
            const float y2 = bflo(uhi) * (w4[2] * acc[4 * g + 2] + b4[2] * c2t + bst) * silu_f(bflo(zhi));
            const float y3 = bfhi(uhi) * (w4[3] * acc[4 * g + 3] + b4[3] * c2t + bst) * silu_f(bfhi(zhi));
            ss += (y0 * y0 + y1 * y1) + (y2 * y2 + y3 * y3);
            *(LAS unsigned long long*)(U_T + o) = (unsigned long long)pkbf(y0, y1) | ((unsigned long long)pkbf(y2, y3) << 32);
        }
        ss += __shfl_xor(ss, 32);
        if (h == 0) yss[t * 4 + db] = ss;
    }
    __syncthreads();
#pragma unroll
    for (int k = 0; k < 4; ++k) {
        const int c = tid + NTHR * k, row = c >> 4, ch = c & 15;
        const f32x4 p4 = *(const LAS f32x4*)(yss + row * 4);
        const float rstd = rsqrtf(((p4[0] + p4[1]) + (p4[2] + p4[3])) * (1.f / 128.f) + EPS);
        const v4u y = *(const LAS v4u*)(U_T + off_b(row, ch)); v4u o;
        o.x = pkbf(bflo(y.x) * rstd, bfhi(y.x) * rstd); o.y = pkbf(bflo(y.y) * rstd, bfhi(y.y) * rstd); o.z = pkbf(bflo(y.z) * rstd, bfhi(y.z) * rstd); o.w = pkbf(bflo(y.w) * rstd, bfhi(y.w) * rstd);
        *(v4u*)(proj + (m0 + row) * NPROJ + OFF_U + head * 128 + 8 * ch) = o;
    }
    __syncthreads();
}
__device__ __forceinline__ void ph_conv(const bf16* proj, const float* cw, const float* cb, bf16* xc, int vcu, int G, int tid) {
    for (size_t i = (size_t)vcu * NTHR + tid; i < (size_t)M_TOK * 2048; i += (size_t)G * NTHR) {
        const int ch = (int)(i & 2047); const size_t m = i >> 11; const int t = (int)(m & (SEQ - 1));
        float a = cb[ch];
#pragma unroll
        for (int j = 0; j < 4; ++j) { const int tt = t - 3 + j; if (tt >= 0) a += cw[j * 2048 + ch] * bf2f(proj[(m - 3 + j) * NPROJ + OFF_XBC + ch]); }
        xc[i] = (bf16)f2bf(silu_f(a));
    }
}
__device__ __forceinline__ float wave_incl_scan(float x, int lane) {
#pragma unroll
    for (int o = 1; o < 64; o <<= 1) { const float y = __shfl_up(x, o); if (lane >= o) x += y; }
    return x;
}
__device__ __forceinline__ int blob_off(int p, int n) { const int nl = n & 31, hh = (nl >> 2) & 1, e = (nl & 3) + 4 * (nl >> 3); return ((((n >> 5) * 2 + (p >> 5)) * 64) + (p & 31) + 32 * hh) * 16 + e; }

template <int NR, class F> __device__ __forceinline__ void conv8_rows(const bf16* raw, int first_valid  , const float* cw, const float* cb, int chan, F&& out) {
    f32x4 w[4][2]; f32x4 bb[2];
#pragma unroll
    for (int j = 0; j < 4; ++j) { w[j][0] = *(const f32x4*)(cw + j * 2048 + chan); w[j][1] = *(const f32x4*)(cw + j * 2048 + chan + 4); }
    bb[0] = *(const f32x4*)(cb + chan); bb[1] = *(const f32x4*)(cb + chan + 4);
    v4u win[NR + 3];
#pragma unroll
    for (int i = 0; i < NR + 3; ++i) { if (i >= first_valid) win[i] = *(const v4u*)(raw + (size_t)i * NPROJ); else win[i] = (v4u){0u, 0u, 0u, 0u}; }
#pragma unroll
    for (int r = 0; r < NR; ++r) {
        float a[8];
#pragma unroll
        for (int e = 0; e < 8; ++e) a[e] = (e < 4) ? bb[0][e] : bb[1][e - 4];
#pragma unroll
        for (int j = 0; j < 4; ++j) { const v4u x = win[r + j];
            a[0] += w[j][0][0] * bflo(x.x); a[1] += w[j][0][1] * bfhi(x.x); a[2] += w[j][0][2] * bflo(x.y); a[3] += w[j][0][3] * bfhi(x.y);
            a[4] += w[j][1][0] * bflo(x.z); a[5] += w[j][1][1] * bfhi(x.z); a[6] += w[j][1][2] * bflo(x.w); a[7] += w[j][1][3] * bfhi(x.w); }
#pragma unroll
        for (int e = 0; e < 8; ++e) a[e] = silu_f(a[e]);
        out(r, a);
    }
}

__device__ __forceinline__ void ssd_state_unit(int unit, const bf16* proj, const float* dt, const float* a_log, const float* cw, const float* cb, bf16* st, float* cdec,
                                               LAS unsigned char* L, int tid, int wave, int lane) {
    LAS unsigned char* B_IMG = L; LAS unsigned char* XW_IMG = L + 32768; LAS float* fsc = (LAS float*)(L + 98304);
    OPAQUE_V(tid); OPAQUE_V(lane);
    const int g = unit & 3, bc = unit >> 2, c = bc & 15;
    const size_t m0 = (size_t)bc * CH;
    if (wave < 4) {
        const int hd = g * 4 + wave; const float a = -__expf(a_log[hd]);
        const float d0 = dt[(m0 + 2 * lane) * 16 + hd], d1 = dt[(m0 + 2 * lane + 1) * 16 + hd];
        const float incl = wave_incl_scan((d0 + d1) * a, lane);
        const float cs1 = incl, cs0 = incl - d1 * a;
        const float cs_end = __shfl(incl, 63);
        fsc[wave * 128 + 2 * lane] = d0 * __expf(cs_end - cs0); fsc[wave * 128 + 2 * lane + 1] = d1 * __expf(cs_end - cs1);
        if (lane == 0) cdec[bc * 16 + hd] = __expf(cs_end);
    }
    __syncthreads();
    if (tid < 384) {
        const int cc = tid % 48, rg = tid / 48;
        const int chan = (cc < 32) ? (g * 256 + 8 * cc) : (1024 + g * 128 + 8 * (cc - 32));
        const int l0 = rg * 16;
        const bf16* raw = proj + (m0 + l0 - 3) * NPROJ + OFF_XBC + chan;
        const int fv = (c == 0 && rg == 0) ? 3 : 0;
        if (cc < 32) { const int r_ = cc >> 3; LAS unsigned char* img = XW_IMG + (cc >> 4) * 32768; const int ch = cc & 15;
            conv8_rows<16>(raw, fv, cw, cb, chan, [&](int r, const float (&a)[8]) { const int l = l0 + r; const float f = fsc[r_ * 128 + l];
                v4u o; o.x = pkbf(a[0] * f, a[1] * f); o.y = pkbf(a[2] * f, a[3] * f); o.z = pkbf(a[4] * f, a[5] * f); o.w = pkbf(a[6] * f, a[7] * f);
                *(LAS v4u*)(img + off_b(l, ch)) = o; });
        } else { const int ch = cc - 32;
            conv8_rows<16>(raw, fv, cw, cb, chan, [&](int r, const float (&a)[8]) { const int l = l0 + r;
                v4u o; o.x = pkbf(a[0], a[1]); o.y = pkbf(a[2], a[3]); o.z = pkbf(a[4], a[5]); o.w = pkbf(a[6], a[7]);
                *(LAS v4u*)(B_IMG + off_b(l, ch)) = o; });
        }
    }
    __syncthreads();
    {
        const int r_ = wave >> 1, pb = wave & 1; const LAS unsigned char* ximg = XW_IMG + (r_ >> 1) * 32768; const int cbx = (r_ & 1) * 2 + pb;
        bf16x8_t xf[8];
#pragma unroll
        for (int ks = 0; ks < 8; ++ks) xf[ks] = frag_tr(ximg, ks, cbx, lane);
        bf16* ob = st + ((size_t)(bc * 16 + g * 4 + r_)) * 8192;
#pragma unroll
        for (int nb = 0; nb < 4; ++nb) {
            f32x16 acc;
#pragma unroll
            for (int i = 0; i < 16; ++i) acc[i] = 0.f;
#pragma unroll
            for (int ks = 0; ks < 8; ++ks) acc = MFMA32(frag_tr(B_IMG, ks, nb, lane), xf[ks], acc);
            v4u o0, o1;
            o0.x = pkbf(acc[0], acc[1]); o0.y = pkbf(acc[2], acc[3]); o0.z = pkbf(acc[4], acc[5]); o0.w = pkbf(acc[6], acc[7]);
            o1.x = pkbf(acc[8], acc[9]); o1.y = pkbf(acc[10], acc[11]); o1.z = pkbf(acc[12], acc[13]); o1.w = pkbf(acc[14], acc[15]);
            v4u* op = (v4u*)(ob + ((nb * 2 + pb) * 64 + lane) * 16);
            op[0] = o0; op[1] = o1;
        }
    }
    __syncthreads();
}
__device__ __forceinline__ void ph_scan_blob(bf16* st, const float* cdec, int vcu, int G, int tid) {
    for (int i = vcu * NTHR + tid; i < NBATCH * 16 * 1024; i += G * NTHR) {
        const int e8 = i & 1023, bh = i >> 10, h = bh & 15, b = bh >> 4;
        float run[8];
#pragma unroll
        for (int k = 0; k < 8; ++k) run[k] = 0.f;
        for (int c = 0; c < NCH; ++c) {
            v4u* p = (v4u*)(st + ((size_t)((b * 16 + c) * 16 + h)) * 8192 + e8 * 8); const v4u s = *p;
            const float dec = cdec[(b * 16 + c) * 16 + h];
            v4u o; o.x = pkbf(run[0], run[1]); o.y = pkbf(run[2], run[3]); o.z = pkbf(run[4], run[5]); o.w = pkbf(run[6], run[7]); *p = o;
            run[0] = run[0] * dec + bflo(s.x); run[1] = run[1] * dec + bfhi(s.x); run[2] = run[2] * dec + bflo(s.y); run[3] = run[3] * dec + bfhi(s.y);
            run[4] = run[4] * dec + bflo(s.z); run[5] = run[5] * dec + bfhi(s.z); run[6] = run[6] * dec + bflo(s.w); run[7] = run[7] * dec + bfhi(s.w);
        }
    }
}
__device__ __forceinline__ void ssd_out_unit_mfma(int unit, bf16* proj, const float* dt, const float* a_log, const float* cw, const float* cb, const bf16* st, const float* dskip,
                                                  LAS unsigned char* L, int tid, int wave, int lane) {
    LAS unsigned char* C_IMG = L; LAS unsigned char* B_IMG = L + 32768; LAS unsigned char* X_IMG = L + 65536;
    LAS float* csv = (LAS float*)(L + 131072); LAS float* dts = csv + 512; LAS float* yss = dts + 512;
    const int g = unit & 3, bc = unit >> 2, c = bc & 15;
    const size_t m0 = (size_t)bc * CH;
    OPAQUE_V(tid); OPAQUE_V(lane);
    if (wave < 4) {
        const int hd = g * 4 + wave; const float a = -__expf(a_log[hd]);
        const float d0 = dt[(m0 + 2 * lane) * 16 + hd], d1 = dt[(m0 + 2 * lane + 1) * 16 + hd];
        const float incl = wave_incl_scan((d0 + d1) * a, lane);
        csv[wave * 128 + 2 * lane] = incl - d1 * a; csv[wave * 128 + 2 * lane + 1] = incl;
        dts[wave * 128 + 2 * lane] = d0; dts[wave * 128 + 2 * lane + 1] = d1;
    }
    {
        const int cc = tid & 63, rg = tid >> 6;
        const int chan = (cc < 32) ? (g * 256 + 8 * cc) : (cc < 48 ? (1024 + g * 128 + 8 * (cc - 32)) : (1536 + g * 128 + 8 * (cc - 48)));
        const int l0 = rg * 16;
        const bf16* raw = proj + (m0 + l0 - 3) * NPROJ + OFF_XBC + chan;
        const int fv = (c == 0 && rg == 0) ? 3 : 0;
        LAS unsigned char* img = (cc < 32) ? (X_IMG + (cc >> 4) * 32768) : (cc < 48 ? B_IMG : C_IMG); const int ch = cc & 15;
        conv8_rows<16>(raw, fv, cw, cb, chan, [&](int r, const float (&a)[8]) { const int l = l0 + r;
            v4u o; o.x = pkbf(a[0], a[1]); o.y = pkbf(a[2], a[3]); o.z = pkbf(a[4], a[5]); o.w = pkbf(a[6], a[7]);
            *(LAS v4u*)(img + off_b(l, ch)) = o; });
    }
    __syncthreads();
    const int lb = wave >> 1, pb = wave & 1;
    OPAQUE_V(lane);
    int hh = lane >> 5, ll = 32 * lb + (lane & 31);
    f32x16 yv[4];
    float csl[4];
#pragma unroll
    for (int r = 0; r < 4; ++r) {
#pragma unroll
        for (int i = 0; i < 16; ++i) yv[r][i] = 0.f;
        csl[r] = csv[r * 128 + ll];
    }
#pragma unroll
    for (int nb = 0; nb < 4; ++nb) {
        bf16x8_t cpf[2];
#pragma unroll
        for (int s2 = 0; s2 < 2; ++s2) {
            const unsigned long long c0 = *(const LAS unsigned long long*)(C_IMG + off_b(ll, 4 * nb + 2 * s2) + 8 * hh);
            const unsigned long long c1 = *(const LAS unsigned long long*)(C_IMG + off_b(ll, 4 * nb + 2 * s2 + 1) + 8 * hh);
            v4u cv; cv.x = (unsigned)c0; cv.y = (unsigned)(c0 >> 32); cv.z = (unsigned)c1; cv.w = (unsigned)(c1 >> 32);
            cpf[s2] = __builtin_bit_cast(bf16x8_t, cv);
        }
#pragma unroll
        for (int r = 0; r < 4; ++r) {
            const v4u* pp = (const v4u*)(st + (size_t)(bc * 16 + g * 4 + r) * 8192 + ((nb * 2 + pb) * 64 + lane) * 16);
            const v4u p0 = pp[0], p1 = pp[1];
            yv[r] = MFMA32(__builtin_bit_cast(bf16x8_t, p0), cpf[0], yv[r]);
            yv[r] = MFMA32(__builtin_bit_cast(bf16x8_t, p1), cpf[1], yv[r]);
        }
    }
#pragma unroll
    for (int r = 0; r < 4; ++r) { const float el = __expf(csl[r]);
#pragma unroll
        for (int i = 0; i < 16; ++i) yv[r][i] *= el; }
    OPAQUE_V(lane); hh = lane >> 5; ll = 32 * lb + (lane & 31);
    {
        bf16x8_t cf[8];
#pragma unroll
        for (int ks = 0; ks < 8; ++ks) cf[ks] = frag_row(C_IMG, lb, ks, lane);
#pragma unroll 1
        for (int sb = 0; sb <= lb; ++sb) {
            f32x16 cbT;
#pragma unroll
            for (int i = 0; i < 16; ++i) cbT[i] = 0.f;
#pragma unroll
            for (int ks = 0; ks < 8; ++ks) cbT = MFMA32(frag_row(B_IMG, sb, ks, lane), cf[ks], cbT);
#pragma unroll
            for (int r = 0; r < 4; ++r) {
                const LAS unsigned char* ximg = X_IMG + (r >> 1) * 32768; const int cbx = (r & 1) * 2 + pb;
                float gT[16];
#pragma unroll
                for (int e = 0; e < 16; ++e) {
                    const int s = 32 * sb + (e & 3) + 8 * (e >> 2) + 4 * hh;
                    const float v = cbT[e] * __expf(fminf(csl[r] - csv[r * 128 + s], 0.f)) * dts[r * 128 + s];
                    gT[e] = (s <= ll) ? v : 0.f;
                }
#pragma unroll
                for (int s2 = 0; s2 < 2; ++s2) {
                    v4u gv; gv.x = pkbf(gT[8 * s2 + 0], gT[8 * s2 + 1]); gv.y = pkbf(gT[8 * s2 + 2], gT[8 * s2 + 3]); gv.z = pkbf(gT[8 * s2 + 4], gT[8 * s2 + 5]); gv.w = pkbf(gT[8 * s2 + 6], gT[8 * s2 + 7]);
                    yv[r] = MFMA32(frag_tr_perm(ximg, 2 * sb + s2, cbx, lane), __builtin_bit_cast(bf16x8_t, gv), yv[r]);
                }
            }
        }
    }
    OPAQUE_V(lane); hh = lane >> 5; ll = 32 * lb + (lane & 31);
#pragma unroll
    for (int r = 0; r < 4; ++r) {
        const float dsk = dskip[g * 4 + r]; const LAS unsigned char* ximg = X_IMG + (r >> 1) * 32768;
#pragma unroll
        for (int gq = 0; gq < 4; ++gq) {
            const unsigned long long x8 = *(const LAS unsigned long long*)(ximg + off_b(ll, (r & 1) * 8 + 4 * pb + gq) + 8 * hh);
            const unsigned xlo = (unsigned)x8, xhi = (unsigned)(x8 >> 32);
            yv[r][4 * gq + 0] += dsk * bflo(xlo); yv[r][4 * gq + 1] += dsk * bfhi(xlo); yv[r][4 * gq + 2] += dsk * bflo(xhi); yv[r][4 * gq + 3] += dsk * bfhi(xhi);
        }
    }
    __syncthreads();
    OPAQUE_V(tid);
#pragma unroll
    for (int k = 0; k < 8; ++k) { const int cidx = tid + NTHR * k, row = cidx >> 5, c32 = cidx & 31;
        *(LAS v4u*)(L + (c32 >> 4) * 32768 + off_b(row, c32 & 15)) = *(const v4u*)(proj + (m0 + row) * NPROJ + OFF_Z + g * 256 + 8 * c32); }
    __syncthreads();
    OPAQUE_V(lane); hh = lane >> 5; ll = 32 * lb + (lane & 31);
    {
        float ss = 0.f;
#pragma unroll
        for (int r = 0; r < 4; ++r) {
            const unsigned ib = (r >> 1) * 32768;
#pragma unroll
            for (int gq = 0; gq < 4; ++gq) {
                const unsigned o = ib + off_b(ll, (r & 1) * 8 + 4 * pb + gq) + 8 * hh;
                const unsigned long long z8 = *(const LAS unsigned long long*)(L + o); const unsigned zlo = (unsigned)z8, zhi = (unsigned)(z8 >> 32);
                const float y0 = yv[r][4 * gq + 0] * silu_f(bflo(zlo)), y1 = yv[r][4 * gq + 1] * silu_f(bfhi(zlo)), y2 = yv[r][4 * gq + 2] * silu_f(bflo(zhi)), y3 = yv[r][4 * gq + 3] * silu_f(bfhi(zhi));
                ss += (y0 * y0 + y1 * y1) + (y2 * y2 + y3 * y3);
                *(LAS unsigned long long*)(X_IMG + o) = (unsigned long long)pkbf(y0, y1) | ((unsigned long long)pkbf(y2, y3) << 32);
            }
        }
        ss += __shfl_xor(ss, 32);
        if (hh == 0) yss[ll * 2 + pb] = ss;
    }
    __syncthreads();
    OPAQUE_V(tid);
#pragma unroll
    for (int k = 0; k < 8; ++k) { const int cidx = tid + NTHR * k, row = cidx >> 5, c32 = cidx & 31;
        const float rstd = rsqrtf((yss[row * 2] + yss[row * 2 + 1]) * (1.f / 256.f) + EPS);
        const v4u y = *(const LAS v4u*)(X_IMG + (c32 >> 4) * 32768 + off_b(row, c32 & 15)); v4u o;
        o.x = pkbf(bflo(y.x) * rstd, bfhi(y.x) * rstd); o.y = pkbf(bflo(y.y) * rstd, bfhi(y.y) * rstd); o.z = pkbf(bflo(y.z) * rstd, bfhi(y.z) * rstd); o.w = pkbf(bflo(y.w) * rstd, bfhi(y.w) * rstd);
        *(v4u*)(proj + (m0 + row) * NPROJ + OFF_V + g * 256 + 8 * c32) = o; }
    __syncthreads();
}
__device__ __forceinline__ void ph_post(const float* xin, const float* mixed, const float* post_w, float* out, bf16* h, int vcu, int G, int wave, int lane) {
    for (int m = vcu * NWAVES + wave; m < M_TOK; m += G * NWAVES) {
        const f32x4* mr = (const f32x4*)(mixed + (size_t)m * DM) + lane; const f32x4* xr = (const f32x4*)(xin + (size_t)m * DM) + lane; const f32x4* pw = (const f32x4*)post_w + lane;
        f32x4 v[4]; float s = 0.f;
#pragma unroll
        for (int j = 0; j < 4; ++j) { v[j] = mr[64 * j]; s += (v[j].x * v[j].x + v[j].y * v[j].y) + (v[j].z * v[j].z + v[j].w * v[j].w); }
        const float rstd = rsqrtf(wave_sum(s) * (1.f / DM) + EPS); float s2 = 0.f;
#pragma unroll
        for (int j = 0; j < 4; ++j) { v[j] = xr[64 * j] + v[j] * rstd * pw[64 * j]; s2 += (v[j].x * v[j].x + v[j].y * v[j].y) + (v[j].z * v[j].z + v[j].w * v[j].w); }
        f32x4* orow = (f32x4*)(out + (size_t)m * DM) + lane;
#pragma unroll
        for (int j = 0; j < 4; ++j) orow[64 * j] = v[j];
        const float rstd2 = rsqrtf(wave_sum(s2) * (1.f / DM) + EPS);
        unsigned long long* o8 = (unsigned long long*)(h + (size_t)m * DM) + lane;
#pragma unroll
        for (int j = 0; j < 4; ++j) o8[64 * j] = (unsigned long long)pk2(v[j].x * rstd2, v[j].y * rstd2) | ((unsigned long long)pk2(v[j].z * rstd2, v[j].w * rstd2) << 32);
    }
}

struct Args { const float* in[16]; float* out; unsigned char* ws; };
__global__ void __launch_bounds__(NTHR, 2) mk_fwd(Args a) {
    extern __shared__ __attribute__((aligned(16))) unsigned char lds[];
    const int tid0 = threadIdx.x;
    const int G = gridDim.x; const int bx = blockIdx.x; const int vcu = (G % 8 == 0) ? (bx % 8) * (G / 8) + bx / 8 : bx;
    LAS unsigned char* L = (LAS unsigned char*)lds;
    volatile LAS unsigned* MISC = (volatile LAS unsigned*)(L + LDSCTL_OFF);
    for (int u = tid0; u < 128; u += NTHR) ((LAS unsigned*)(L + LDSCTL_OFF))[u] = 0u;
    __syncthreads();
    typedef __attribute__((address_space(4))) const unsigned char* kptr_t;
    const kptr_t kp0 = (kptr_t)__builtin_amdgcn_kernarg_segment_ptr();
#define KP_FRESH kptr_t kp = kp0; asm volatile("" : "+s"(kp)); int tid = tid0; asm volatile("" : "+v"(tid)); const int lane = tid & 63, wave = __builtin_amdgcn_readfirstlane(tid >> 6); (void)lane; (void)wave
#define KIN(i) (*(const float* const __attribute__((address_space(4)))*)(kp + 8 * (i)))
#define KOUT (*(float* const __attribute__((address_space(4)))*)(kp + 8 * 16))
#define KWS (*(unsigned char* const __attribute__((address_space(4)))*)(kp + 8 * 17))
    XcdBarrier bar;
    { KP_FRESH; bar = xcd_barrier_post((unsigned*)(KWS + WS_CTL) + CW_BAR, MISC + 8); }

    { KP_FRESH; unsigned char* ws = KWS;
      ph_prep_w(KIN(2), KIN(1), KIN(14), KIN(7), KIN(13), (bf16*)(ws + WS_WIN), (bf16*)(ws + WS_WOUT), (float*)(ws + WS_WDT), lds, vcu, G, wave, lane, tid);
      ph_h0(KIN(0), (bf16*)(ws + WS_H), vcu, G, wave, lane);
      ph_prep_gmlp(KIN(5), ws + WS_WCI, (float*)(ws + WS_C2), vcu, G, wave, lane); }
    xcd_barrier(bar);
    for (int l = 0; l < DEPTH; ++l) {
        {
            KP_FRESH; unsigned char* ws = KWS;
            pg8::Gemm g{(bf16*)(ws + WS_H), (bf16*)(ws + WS_WIN), M_TOK, NPROJ, DM, DM}; pg8::StaticOrder S; S.init(M_TOK, NPROJ, G, bx);
            pg8::EpiProj E{(bf16*)(ws + WS_PROJ), NPROJ, (float*)(ws + WS_VPART), M_TOK};
            pg8::gemm_phase<pg8::EpiProj, pg8::StaticOrder, true, true>(L, g, S, E);
        }
        { KP_FRESH; unsigned char* ws = KWS; ph_dt((bf16*)(ws + WS_H), (float*)(ws + WS_WDT), KIN(10) + l * 16, (float*)(ws + WS_DT), vcu, G, wave, lane); }
        xcd_barrier(bar);
        { KP_FRESH; unsigned char* ws = KWS;
          for (int u = vcu; u < NBATCH * NCH * 4; u += G) ssd_state_unit(u, (bf16*)(ws + WS_PROJ), (float*)(ws + WS_DT), KIN(11) + l * 16, KIN(8) + (size_t)l * 4 * 2048, KIN(9) + l * 2048, (bf16*)(ws + WS_ST), (float*)(ws + WS_CDEC), L, tid, wave, lane); }
        xcd_barrier(bar);
        { KP_FRESH; unsigned char* ws = KWS; ph_scan_blob((bf16*)(ws + WS_ST), (float*)(ws + WS_CDEC), vcu, G, tid); }
        { KP_FRESH; unsigned char* ws = KWS; bf16* proj = (bf16*)(ws + WS_PROJ);
          for (int u = vcu, first = 1; u < NBATCH * NCH * 8; u += G, first = 0) gmlp_unit_mfma(u, first != 0, proj, (const float*)(ws + WS_VPART), KIN(3) + l * 1024, KIN(4) + l * 1024, ws + WS_WCI + (size_t)l * 8 * 32768, (const float*)(ws + WS_C2) + l * 1024, KIN(6) + l * 1024, L, tid, wave, lane);
 }
        xcd_barrier(bar);
        { KP_FRESH; unsigned char* ws = KWS;
          for (int u = vcu; u < NBATCH * NCH * 4; u += G) ssd_out_unit_mfma(u, (bf16*)(ws + WS_PROJ), (float*)(ws + WS_DT), KIN(11) + l * 16, KIN(8) + (size_t)l * 4 * 2048, KIN(9) + l * 2048, (bf16*)(ws + WS_ST), KIN(12) + l * 16, L, tid, wave, lane); }
        xcd_barrier(bar);
        {
            KP_FRESH; unsigned char* ws = KWS;
            pg8::Gemm g{(bf16*)(ws + WS_PROJ), (bf16*)(ws + WS_WOUT), M_TOK, DM, 2048, NPROJ}; pg8::StaticOrder S; S.init(M_TOK, DM, G, bx);
            pg8::EpiF32 E{(float*)(ws + WS_MIXED), DM, nullptr};
            pg8::gemm_phase<pg8::EpiF32, pg8::StaticOrder, true, true>(L, g, S, E);
        }
        xcd_barrier(bar);
        { KP_FRESH; unsigned char* ws = KWS; float* out = KOUT;
          ph_post(l == 0 ? KIN(0) : out, (float*)(ws + WS_MIXED), KIN(15) + l * DM, out, (bf16*)(ws + WS_H), vcu, G, wave, lane);
          if (l + 1 < DEPTH)
            ph_prep_w(KIN(2) + (size_t)(l + 1) * DM * INCOLS, KIN(1) + (l + 1) * DM, KIN(14) + (size_t)(l + 1) * 2048 * DM, KIN(7) + (l + 1) * 1024, KIN(13) + (l + 1) * 1024,
                      (bf16*)(ws + WS_WIN), (bf16*)(ws + WS_WOUT), (float*)(ws + WS_WDT), lds, vcu, G, wave, lane, tid); }
        if (l + 1 < DEPTH) xcd_barrier(bar);
    }
}

extern "C" void kernel_launch(void* const* d_in, const int* in_sizes, int n_in, void* d_out, int out_size, void* d_ws, size_t ws_size, hipStream_t stream) {
    static int grid = 0;
    if (grid == 0) {
        if (n_in != 16 || ws_size < WS_END || out_size != M_TOK * DM) { fprintf(stderr, "kernel_launch: unexpected arguments (n_in %d, ws %zu, out %d)\n", n_in, ws_size, out_size); grid = -1; return; }
        int dev = 0, cus = 0, per_cu = 0;
        if (hipGetDevice(&dev) != hipSuccess || hipDeviceGetAttribute(&cus, hipDeviceAttributeMultiprocessorCount, dev) != hipSuccess) { grid = -1; return; }
        if (hipFuncSetAttribute((const void*)mk_fwd, hipFuncAttributeMaxDynamicSharedMemorySize, LDS_BYTES) != hipSuccess) { fprintf(stderr, "kernel_launch: hipFuncSetAttribute failed\n"); grid = -1; return; }
        if (hipOccupancyMaxActiveBlocksPerMultiprocessor(&per_cu, (const void*)mk_fwd, NTHR, LDS_BYTES) != hipSuccess || per_cu < 1) { fprintf(stderr, "kernel_launch: occupancy query says %d blocks per CU\n", per_cu); grid = -1; (void)hipGetLastError(); return; }
        grid = cus;
        if (grid != 256) { fprintf(stderr, "kernel_launch: %d CUs, expected 256\n", grid); }
    }
    if (grid < 0) return;
    (void)hipMemsetAsync((char*)d_ws + WS_CTL, 0, 1 * MiB, stream);
    Args a{};
    for (int i = 0; i < 16; ++i) a.in[i] = (const float*)d_in[i];
    a.out = (float*)d_out; a.ws = (unsigned char*)d_ws;
    hipLaunchKernelGGL(mk_fwd, dim3(grid), dim3(NTHR), LDS_BYTES, stream, a);
}
```
